# Optimizing an MI355X kernel written in HIP

```python
import math
import jax
import jax.numpy as jnp
from jax import lax
import numpy as np

D_MODEL = 1024
BATCH = 2
SEQ = 16384
DEPTH = 2
DEC_BATCH = 16
DEC_SEQ = 16
PAST_LEN = 1024

CHUNK = 64
Q_BLOCK = 128
H_A = D_MODEL // 256
HD_A = 64
H_B = D_MODEL // 256
DK_B = 32
DV_B = 64
GLA_RANK = 16
GLA_TAU = 16.0
H_C = D_MODEL // 256
HD_C = 64
W_A = H_A * HD_A
W_B = H_B * DV_B
W_C = H_C * 2 * HD_C
D_MIX = W_A + W_B + W_C
D_FF = ((8 * D_MODEL // 3 + 255) // 256) * 256
N_SUB = 3
PROJ_SIZES = (W_A, W_A, W_A, H_A, H_B * DK_B, H_B * DK_B, W_B, GLA_RANK, W_B, 2 * H_C * HD_C, 2 * H_C * HD_C, W_C)
D_PROJ = sum(PROJ_SIZES)
NEG = -1e30
EPS = 1e-6

kernel_name = 'hybrid_stream_encoder_step'


def rmsnorm(x, g):
    xf = x.astype(jnp.float32)
    y = xf * lax.rsqrt(jnp.mean(xf * xf, axis=-1, keepdims=True) + EPS)
    return (y * g.astype(jnp.float32)).astype(x.dtype)


def swiglu(h, w_in, w_out):
    gate, up = jnp.split(h @ w_in, 2, axis=-1)
    return (jax.nn.silu(gate) * up) @ w_out


def project(h, w_in, b_f, w_gla_up, b_gla_up):
    b, t, _ = h.shape
    offsets = [int(o) for o in np.cumsum(PROJ_SIZES)[:-1]]
    qa, ka, va, fa, qb, kb, vb, gb, rb, qc, kc, vc = jnp.split(h @ w_in, offsets, axis=-1)
    loga = jax.nn.log_sigmoid((gb @ w_gla_up + b_gla_up).astype(jnp.float32)) / GLA_TAU
    return dict(
        q_a=qa.reshape(b, t, H_A, HD_A), k_a=ka.reshape(b, t, H_A, HD_A), v_a=va.reshape(b, t, H_A, HD_A),
        logf=jax.nn.log_sigmoid(fa.astype(jnp.float32) + b_f.astype(jnp.float32)),
        q_b=qb.reshape(b, t, H_B, DK_B), k_b=kb.reshape(b, t, H_B, DK_B), v_b=vb.reshape(b, t, H_B, DV_B),
        loga=loga.reshape(b, t, H_B, DK_B), r_b=rb.reshape(b, t, H_B, DV_B),
        q_c=qc.reshape(b, t, H_C, 2, HD_C), k_c=kc.reshape(b, t, H_C, 2, HD_C), v_c=vc.reshape(b, t, H_C, 2 * HD_C))


def fox_block(q, k, v, cq, ck, pos_q, pos_k):
    s = jnp.einsum('bqhd,bkhd->bhqk', q, k).astype(jnp.float32) * (HD_A ** -0.5)
    s = s + jnp.transpose(cq, (0, 2, 1))[..., :, None] - jnp.transpose(ck, (0, 2, 1))[..., None, :]
    mask = pos_k[None, :] <= pos_q[:, None]
    p = jax.nn.softmax(jnp.where(mask, s, NEG), axis=-1)
    return jnp.einsum('bhqk,bkhd->bqhd', p.astype(v.dtype), v)


def diff_block(q, k, v, pos_q, pos_k, lam, slopes):
    s = jnp.einsum('bqhmd,bkhmd->bmhqk', q, k).astype(jnp.float32) * (HD_C ** -0.5)
    dist = jnp.abs(pos_q[:, None] - pos_k[None, :]).astype(jnp.float32)
    bias = -slopes[:, None, None] * dist
    mask = (pos_k // CHUNK)[None, :] <= (pos_q // CHUNK)[:, None]
    p = jax.nn.softmax(jnp.where(mask, s + bias, NEG), axis=-1)
    w = p[:, 0] - lam * p[:, 1]
    return jnp.einsum('bhqk,bkhe->bqhe', w.astype(v.dtype), v)


def sweep_query_blocks(block_fn, q_arrays, seq):
    nb = seq // Q_BLOCK

    def one(i):
        start = i * Q_BLOCK
        qs = [lax.dynamic_slice_in_dim(a, start, Q_BLOCK, axis=1) for a in q_arrays]
        return block_fn(*qs, start + jnp.arange(Q_BLOCK))

    out = jnp.moveaxis(lax.map(one, jnp.arange(nb)), 0, 1)
    return out.reshape((out.shape[0], seq) + out.shape[3:])


def gla_chunked(q, k, v, loga, s0):
    b, t, h, dk = q.shape
    dv = v.shape[-1]
    L = min(CHUNK, t)
    n = t // L
    rs = lambda a: a.astype(jnp.float32).reshape(b, n, L, h, a.shape[-1])
    q = rs(q) * (dk ** -0.5)
    k = rs(k)
    v = rs(v)
    cb = jnp.cumsum(rs(loga), axis=2)
    qe = q * jnp.exp(cb)
    ke = k * jnp.exp(-cb)
    kl = k * jnp.exp(cb[:, :, -1:] - cb)
    decay = jnp.exp(cb[:, :, -1])
    causal = jnp.tril(jnp.ones((L, L), dtype=bool))
    a = jnp.where(causal, jnp.einsum('bnlhk,bnmhk->bnhlm', qe, ke), 0.0)
    o_intra = jnp.einsum('bnhlm,bnmhv->bnlhv', a, v)

    def step(S, xs):
        qe_c, kl_c, v_c, dec_c = xs
        o = jnp.einsum('blhk,bhkv->blhv', qe_c, S)
        S = dec_c[..., None] * S + jnp.einsum('blhk,blhv->bhkv', kl_c, v_c)
        return S, o

    xs = (jnp.moveaxis(qe, 1, 0), jnp.moveaxis(kl, 1, 0), jnp.moveaxis(v, 1, 0), jnp.moveaxis(decay, 1, 0))
    s_fin, o_inter = lax.scan(step, s0.astype(jnp.float32), xs)
    o = o_intra + jnp.moveaxis(o_inter, 0, 1)
    return o.reshape(b, t, h, dv), s_fin


def merge_heads(o_a, o_b, r_b, o_c, g_gla, g_diff, lam_init, w_out):
    b, t = o_a.shape[:2]
    dt = o_a.dtype
    gla = rmsnorm(o_b, g_gla) * jax.nn.silu(r_b.astype(jnp.float32))
    dif = rmsnorm(o_c.astype(jnp.float32), g_diff) * (1.0 - lam_init)
    cat = jnp.concatenate([o_a.reshape(b, t, W_A), gla.reshape(b, t, W_B).astype(dt), dif.reshape(b, t, W_C).astype(dt)], axis=-1)
    return cat @ w_out


def setup_inputs(seed: int = 0) -> dict:
    key = jax.random.key(seed)
    ks = jax.random.split(key, 24)
    nrm = lambda k, shape, s=1.0: s * jax.random.normal(k, shape, jnp.float32)
    return {
        'x_prompt': nrm(ks[0], (BATCH, SEQ, D_MODEL)),
        'x_sample': nrm(ks[1], (DEC_BATCH, DEC_SEQ, D_MODEL)),
        'c_prompt': nrm(ks[2], (BATCH, D_MODEL)),
        'c_sample': nrm(ks[3], (DEC_BATCH, D_MODEL)),
        'cache_fox_k': nrm(ks[4], (DEPTH, DEC_BATCH, PAST_LEN, H_A, HD_A)),
        'cache_fox_v': nrm(ks[5], (DEPTH, DEC_BATCH, PAST_LEN, H_A, HD_A)),
        'cache_fox_logf': jax.nn.log_sigmoid(nrm(ks[6], (DEPTH, DEC_BATCH, PAST_LEN, H_A))),
        'state_gla': nrm(ks[7], (DEPTH, DEC_BATCH, H_B, DK_B, DV_B)),
        'cache_diff_k': nrm(ks[8], (DEPTH, DEC_BATCH, PAST_LEN, H_C, 2 * HD_C)),
        'cache_diff_v': nrm(ks[9], (DEPTH, DEC_BATCH, PAST_LEN, H_C, 2 * HD_C)),
        'w_ada': nrm(ks[10], (DEPTH, D_MODEL, N_SUB * 3 * D_MODEL), 0.5 * D_MODEL ** -0.5),
        'b_ada': nrm(ks[11], (DEPTH, N_SUB * 3 * D_MODEL), 0.02),
        'g_norm': 1.0 + nrm(ks[12], (DEPTH, 2 * N_SUB, D_MODEL), 0.1),
        'w_ffn_in': nrm(ks[13], (DEPTH, 2, D_MODEL, 2 * D_FF), D_MODEL ** -0.5),
        'w_ffn_out': nrm(ks[14], (DEPTH, 2, D_FF, D_MODEL), D_FF ** -0.5),
        'w_in': nrm(ks[15], (DEPTH, D_MODEL, D_PROJ), D_MODEL ** -0.5),
        'b_f': nrm(ks[16], (DEPTH, H_A), 0.1),
        'w_gla_up': nrm(ks[17], (DEPTH, GLA_RANK, H_B * DK_B), GLA_RANK ** -0.5),
        'b_gla_up': nrm(ks[18], (DEPTH, H_B * DK_B), 0.1),
        'g_gla': 1.0 + nrm(ks[19], (DEPTH, DV_B), 0.1),
        'g_diff': 1.0 + nrm(ks[20], (DEPTH, 2 * HD_C), 0.1),
        'lam_params': nrm(ks[21], (DEPTH, 4, HD_C), 0.1),
        'w_out': nrm(ks[22], (DEPTH, D_MIX, D_MODEL), D_MIX ** -0.5),
    }


def reference(x_prompt, x_sample, c_prompt, c_sample, cache_fox_k, cache_fox_v, cache_fox_logf, state_gla,
              cache_diff_k, cache_diff_v, w_ada, b_ada, g_norm, w_ffn_in, w_ffn_out, w_in, b_f, w_gla_up,
              b_gla_up, g_gla, g_diff, lam_params, w_out):
    slopes = 2.0 ** (-8.0 * jnp.arange(1, H_C + 1, dtype=jnp.float32) / H_C)

    def diff_lambda(l):
        lp = lam_params[l].astype(jnp.float32)
        lam_init = 0.8 - 0.6 * math.exp(-0.3 * l)
        lam = jnp.exp(jnp.sum(lp[0] * lp[1])) - jnp.exp(jnp.sum(lp[2] * lp[3])) + lam_init
        return lam, lam_init

    def prompt_mixer(l, h):
        b, t, _ = h.shape
        p = project(h, w_in[l], b_f[l], w_gla_up[l], b_gla_up[l])
        pos_k = jnp.arange(t)
        c_cum = jnp.cumsum(p['logf'], axis=1)
        o_a = sweep_query_blocks(
            lambda qi, cqi, pos_q: fox_block(qi, p['k_a'], p['v_a'], cqi, c_cum, pos_q, pos_k),
            (p['q_a'], c_cum), t)
        o_b, s_b = gla_chunked(p['q_b'], p['k_b'], p['v_b'], p['loga'], jnp.zeros((b, H_B, DK_B, DV_B), jnp.float32))
        lam, lam_init = diff_lambda(l)
        o_c = sweep_query_blocks(
            lambda qi, pos_q: diff_block(qi, p['k_c'], p['v_c'], pos_q, pos_k, lam, slopes),
            (p['q_c'],), t)
        out = merge_heads(o_a, o_b, p['r_b'], o_c, g_gla[l], g_diff[l], lam_init, w_out[l])
        return out, (p['k_a'], p['v_a'], p['logf'], s_b, p['k_c'].reshape(b, t, H_C, 2 * HD_C), p['v_c'])

    def sample_mixer(l, h):
        b, t, _ = h.shape
        past = cache_fox_k.shape[2]
        p = project(h, w_in[l], b_f[l], w_gla_up[l], b_gla_up[l])
        pos_q = past + jnp.arange(t)
        pos_k = jnp.arange(past + t)
        k_a = jnp.concatenate([cache_fox_k[l].astype(h.dtype), p['k_a']], axis=1)
        v_a = jnp.concatenate([cache_fox_v[l].astype(h.dtype), p['v_a']], axis=1)
        c_all = jnp.cumsum(jnp.concatenate([cache_fox_logf[l].astype(jnp.float32), p['logf']], axis=1), axis=1)
        o_a = fox_block(p['q_a'], k_a, v_a, c_all[:, past:], c_all, pos_q, pos_k)
        o_b, s_b = gla_chunked(p['q_b'], p['k_b'], p['v_b'], p['loga'], state_gla[l])
        lam, lam_init = diff_lambda(l)
        k_c = jnp.concatenate([cache_diff_k[l].astype(h.dtype).reshape(b, past, H_C, 2, HD_C), p['k_c']], axis=1)
        v_c = jnp.concatenate([cache_diff_v[l].astype(h.dtype), p['v_c']], axis=1)
        o_c = diff_block(p['q_c'], k_c, v_c, pos_q, pos_k, lam, slopes)
        out = merge_heads(o_a, o_b, p['r_b'], o_c, g_gla[l], g_diff[l], lam_init, w_out[l])
        return out, (p['k_a'], p['v_a'], p['logf'], s_b, p['k_c'].reshape(b, t, H_C, 2 * HD_C), p['v_c'])

    def trunk(x, c, mixer):
        b = x.shape[0]
        states = []
        for l in range(DEPTH):
            mod = (jax.nn.silu(c) @ w_ada[l] + b_ada[l]).reshape(b, N_SUB, 3, D_MODEL)

            def pre(x, s):
                h = rmsnorm(x, g_norm[l, 2 * s])
                return h * (1.0 + mod[:, s, 1][:, None, :]) + mod[:, s, 0][:, None, :]

            def post(x, s, y, res_w):
                return x + res_w * mod[:, s, 2][:, None, :] * rmsnorm(y, g_norm[l, 2 * s + 1])

            x = post(x, 0, swiglu(pre(x, 0), w_ffn_in[l, 0], w_ffn_out[l, 0]), 0.5)
            y, st = mixer(l, pre(x, 1))
            x = post(x, 1, y, 1.0)
            x = post(x, 2, swiglu(pre(x, 2), w_ffn_in[l, 1], w_ffn_out[l, 1]), 0.5)
            states.append(st)
        stacked = [jnp.stack([st[i] for st in states]) for i in range(6)]
        return x, stacked

    y_prompt, sp = trunk(x_prompt, c_prompt, prompt_mixer)
    y_sample, ss = trunk(x_sample, c_sample, sample_mixer)
    return (y_prompt, y_sample, sp[0], sp[1], sp[2], sp[3], sp[4], sp[5], ss[0], ss[1], ss[2], ss[3], ss[4], ss[5])
```

```cpp
#include <hip/hip_runtime.h>
#include <hip/hip_cooperative_groups.h>
#include <hip/hip_bf16.h>
#include <cstdio>
#include <cstdint>
namespace cg = cooperative_groups;
extern __shared__ __attribute__((aligned(16))) unsigned char lds_raw[];
constexpr int LDS_WTAB = 147456 - 96;
__device__ __forceinline__ int lt_tid() {
    const unsigned hw = (unsigned)__builtin_amdgcn_s_getreg((5 << 11) | 4) & 63u;
    int w = ((const __attribute__((address_space(3))) unsigned char*)lds_raw)[LDS_WTAB + hw];
    unsigned z = 0u; asm volatile("" : "+v"(z));
    int t = (w << 6) | (int)__builtin_amdgcn_mbcnt_hi(~0u, __builtin_amdgcn_mbcnt_lo(~0u, z));
    asm volatile("" : "+v"(t)); return t;
}
namespace pg8 {
#define PG8_LAS __attribute__((address_space(3)))
typedef unsigned short bf16_t;
typedef short bf16x8 __attribute__((ext_vector_type(8)));
typedef float f32x4 __attribute__((ext_vector_type(4)));
typedef unsigned u32x4 __attribute__((ext_vector_type(4)));
constexpr int BM = 256, BK = 64, HALF = 128, HTB = HALF * BK * 2  , STAGE_BYTES = 8 * HTB, NXCD = 8, WGM = 8;

__host__ __device__ __forceinline__ int lds_byte(int r, int c) { const int st = (r >> 4) * 2 + (c >> 5), rr = r & 15, cc = c & 31, ob = rr * 64 + cc * 2; return st * 1024 + (ob ^ (((ob >> 9) & 1) << 5)); }
__host__ __device__ __forceinline__ void stage_rc(int b, int& R, int& C) { const int st = b / 1024, sb = b % 1024, swz = sb ^ (((sb >> 9) & 1) << 5); R = (st >> 1) * 16 + swz / 64; C = (st & 1) * 32 + (swz % 64) / 2; }
__host__ __device__ __forceinline__ int perm32(int rho) { const int n = rho >> 4, i = rho & 15; return 8 * (i >> 2) + 4 * n + (i & 3); }

struct Unit { int pm, pn; };
struct Gemm { const bf16_t* A; const bf16_t* Bt; int M, N, K; };

struct StaticOrder {
    int nM, nN, nwg, G, c;
    __host__ __device__ void init(int M, int N, int G_, int c_) { nM = M / BM; nN = N / BM; nwg = nM * nN; G = G_; c = c_; }
    __host__ __device__ bool next(int i, Unit& u) const {
        const long L = (long)i * G + c; if (L >= nwg) return false;
        int wgid = (int)L; { const int q = nwg / NXCD, r = nwg % NXCD, xcd = wgid % NXCD, off = wgid / NXCD; wgid = (xcd < r ? xcd * (q + 1) : r * (q + 1) + (xcd - r) * q) + off; }
        const int nig = WGM * nN, gid = wgid / nig, fm = gid * WGM, gsz = (nM - fm) < WGM ? (nM - fm) : WGM;
        u.pm = fm + ((wgid % nig) % gsz); u.pn = (wgid % nig) / gsz; return true;
    }
    __device__ __forceinline__ void a_ready(const Unit&) const {}
    __device__ __forceinline__ void done(const Unit&) const {}
};

__device__ __forceinline__ unsigned cvt_pk_bf16(float lo, float hi) { unsigned r; asm volatile("v_cvt_pk_bf16_f32 %0, %1, %2" : "=v"(r) : "v"(lo), "v"(hi)); return r; }
template <class Epi, class Sched, bool ALIGN_EPI = false, bool SP2 = false>
__device__ __forceinline__ void gemm_phase(PG8_LAS unsigned char* lds, const Gemm g, const Sched& S, const Epi& E) {
    const int tid = lt_tid(), wid = __builtin_amdgcn_readfirstlane(tid >> 6), lane = tid & 63, wr = wid >> 2, wc = wid & 3, fr = lane & 15, fq = lane >> 4;
    const int K = g.K, nt = K / BK;
    unsigned voffA[2], voffB[2];
#pragma unroll
    for (int i = 0; i < 2; ++i) { int R, C; stage_rc(tid * 16 + i * 8192, R, C); const int Rb = Epi::PERM ? ((R & ~31) + perm32(R & 31)) : R;
        voffA[i] = (unsigned)(R * K + C) * 2u; voffB[i] = (unsigned)(Rb * K + C) * 2u; }
    const size_t kstep = (size_t)(BK * 2);
    const size_t hstep = (size_t)HALF * K * 2;
    const size_t tstep = 2 * hstep;
    const unsigned ldsw = (unsigned)wid * 1024u;
    const int aoff = lds_byte(wr * 64 + fr, fq * 8), boff = lds_byte(wc * 32 + fr, fq * 8);
#define PG8_SA(b, h) (((b) * 2 + (h)) * HTB)
#define PG8_SB(b, h) ((4 + (b) * 2 + (h)) * HTB)
#define PG8_STAGE(bufoff, gbase, voff) do { _Pragma("unroll") for (int _i = 0; _i < 2; ++_i) \
        __builtin_amdgcn_global_load_lds((const unsigned*)((const char*)(gbase) + (voff)[_i]), (PG8_LAS unsigned*)(lds + (bufoff) + ldsw + _i * 8192), 16, 0, 0); } while (0)
#define PG8_LDA(dst, b, h) do { _Pragma("unroll") for (int m = 0; m < 4; ++m) _Pragma("unroll") for (int k = 0; k < 2; ++k) dst[m][k] = *(const PG8_LAS bf16x8*)(lds + PG8_SA(b, h) + aoff + m * 2048 + k * 1024); } while (0)
#define PG8_LDB(dst, b, h) do { _Pragma("unroll") for (int n = 0; n < 2; ++n) _Pragma("unroll") for (int k = 0; k < 2; ++k) dst[n][k] = *(const PG8_LAS bf16x8*)(lds + PG8_SB(b, h) + boff + n * 2048 + k * 1024); } while (0)
#define PG8_MMA(ai, bj, At, Bt) do { __builtin_amdgcn_s_setprio(1); _Pragma("unroll") for (int m = 0; m < 4; ++m) _Pragma("unroll") for (int n = 0; n < 2; ++n) _Pragma("unroll") for (int k = 0; k < 2; ++k) \
        acc[ai][bj][m][n] = __builtin_amdgcn_mfma_f32_16x16x32_bf16(Bt[n][k], At[m][k], acc[ai][bj][m][n], 0, 0, 0); __builtin_amdgcn_s_setprio(0); } while (0)
#define PG8_WAIT_V(n) asm volatile("s_waitcnt vmcnt(" #n ")" ::: "memory")
#define PG8_WAIT_L(n) asm volatile("s_waitcnt lgkmcnt(" #n ")" ::: "memory")
#define PG8_BAR __builtin_amdgcn_s_barrier()
#define PG8_SCHED __builtin_amdgcn_sched_barrier(0)
    Unit cur, nxt; int ui = 0;
    if (!S.next(0, cur)) return;
    f32x4 acc[2][2][4][2];
#pragma unroll
    for (int a = 0; a < 2; ++a)
#pragma unroll
        for (int b = 0; b < 2; ++b)
#pragma unroll
            for (int m = 0; m < 4; ++m)
#pragma unroll
                for (int n = 0; n < 2; ++n) acc[a][b][m][n] = (f32x4){0.f, 0.f, 0.f, 0.f};
    bf16x8 At[4][2], B0[2][2], B1[2][2];
    const char* cA = (const char*)g.A + (size_t)cur.pm * tstep; const char* cB = (const char*)g.Bt + (size_t)cur.pn * tstep;
    S.a_ready(cur);
    if constexpr (SP2) {
        PG8_STAGE(PG8_SB(0, 0), cB, voffB); PG8_STAGE(PG8_SB(0, 1), cB + hstep, voffB); PG8_STAGE(PG8_SA(0, 0), cA, voffA); PG8_STAGE(PG8_SA(0, 1), cA + hstep, voffA);
        if (wr == 1) PG8_BAR;
        PG8_WAIT_V(2); PG8_BAR;
        PG8_STAGE(PG8_SB(1, 0), cB + kstep, voffB); PG8_STAGE(PG8_SA(1, 0), cA + kstep, voffA); PG8_STAGE(PG8_SB(1, 1), cB + hstep + kstep, voffB);
        PG8_WAIT_V(6); PG8_BAR;
    } else {
        PG8_STAGE(PG8_SB(0, 0), cB, voffB); PG8_STAGE(PG8_SA(0, 0), cA, voffA); PG8_STAGE(PG8_SB(0, 1), cB + hstep, voffB); PG8_STAGE(PG8_SA(0, 1), cA + hstep, voffA);
        if (wr == 1) PG8_BAR;
        PG8_WAIT_V(4); PG8_BAR;
        PG8_STAGE(PG8_SB(1, 0), cB + kstep, voffB); PG8_STAGE(PG8_SA(1, 0), cA + kstep, voffA); PG8_STAGE(PG8_SB(1, 1), cB + hstep + kstep, voffB);
        PG8_WAIT_V(6); PG8_BAR;
    }
    for (;;) {
        const bool has_next = S.next(ui + 1, nxt);
        const char* nA = has_next ? (const char*)g.A + (size_t)nxt.pm * tstep : cA; const char* nB = has_next ? (const char*)g.Bt + (size_t)nxt.pn * tstep : cB;
        for (int t = 0; t < nt; t += 2) {
            const bool last = (t == nt - 2);
            const char* a1 = cA + (size_t)(t + 1) * kstep;
            const char* a2 = last ? nA : cA + (size_t)(t + 2) * kstep; const char* b2 = last ? nB : cB + (size_t)(t + 2) * kstep;
            const char* a3 = a2 + kstep; const char* b3 = b2 + kstep;
            if (last && has_next) S.a_ready(nxt);
            if constexpr (SP2) {
            PG8_LDB(B0, 0, 0); PG8_LDB(B1, 0, 1); PG8_SCHED; PG8_LDA(At, 0, 0); PG8_STAGE(PG8_SA(1, 1), a1 + hstep, voffA);
            PG8_WAIT_V(8); PG8_WAIT_L(0); PG8_BAR; PG8_MMA(0, 0, At, B0); PG8_MMA(0, 1, At, B1); PG8_BAR; PG8_SCHED;
            PG8_LDA(At, 0, 1); PG8_STAGE(PG8_SB(0, 0), b2, voffB); PG8_STAGE(PG8_SB(0, 1), b2 + hstep, voffB); PG8_STAGE(PG8_SA(0, 0), a2, voffA);
            PG8_WAIT_V(8); PG8_WAIT_L(0); PG8_BAR; PG8_MMA(1, 0, At, B0); PG8_MMA(1, 1, At, B1); PG8_BAR; PG8_SCHED;
            PG8_LDB(B0, 1, 0); PG8_LDB(B1, 1, 1); PG8_SCHED; PG8_LDA(At, 1, 0); PG8_STAGE(PG8_SA(0, 1), a2 + hstep, voffA);
            PG8_WAIT_V(8); PG8_WAIT_L(0); PG8_BAR; PG8_MMA(0, 0, At, B0); PG8_MMA(0, 1, At, B1); PG8_BAR; PG8_SCHED;
            PG8_LDA(At, 1, 1); PG8_STAGE(PG8_SB(1, 0), b3, voffB); PG8_STAGE(PG8_SB(1, 1), b3 + hstep, voffB); PG8_STAGE(PG8_SA(1, 0), a3, voffA);
            PG8_WAIT_V(8); PG8_WAIT_L(0); PG8_BAR; PG8_MMA(1, 0, At, B0); PG8_MMA(1, 1, At, B1); PG8_BAR; PG8_SCHED;
            } else {
            PG8_LDB(B0, 0, 0); PG8_SCHED; PG8_LDA(At, 0, 0); PG8_STAGE(PG8_SA(1, 1), a1 + hstep, voffA);
            PG8_WAIT_L(8); PG8_BAR; PG8_WAIT_L(0); PG8_MMA(0, 0, At, B0); PG8_BAR; PG8_SCHED;
            PG8_LDB(B1, 0, 1); PG8_STAGE(PG8_SB(0, 0), b2, voffB);
            PG8_BAR; PG8_WAIT_L(0); PG8_MMA(0, 1, At, B1); PG8_BAR;
            PG8_LDA(At, 0, 1); PG8_STAGE(PG8_SA(0, 0), a2, voffA);
            PG8_BAR; PG8_WAIT_L(0); PG8_MMA(1, 0, At, B0); PG8_BAR; PG8_SCHED;
            PG8_STAGE(PG8_SB(0, 1), b2 + hstep, voffB);
            PG8_WAIT_V(6); PG8_BAR; PG8_MMA(1, 1, At, B1); PG8_BAR;
            PG8_LDB(B0, 1, 0); PG8_SCHED; PG8_LDA(At, 1, 0); PG8_STAGE(PG8_SA(0, 1), a2 + hstep, voffA);
            PG8_WAIT_L(8); PG8_BAR; PG8_WAIT_L(0); PG8_MMA(0, 0, At, B0); PG8_BAR; PG8_SCHED;
            PG8_LDB(B1, 1, 1); PG8_STAGE(PG8_SB(1, 0), b3, voffB);
            PG8_BAR; PG8_WAIT_L(0); PG8_MMA(0, 1, At, B1); PG8_BAR;
            PG8_LDA(At, 1, 1); PG8_STAGE(PG8_SA(1, 0), a3, voffA);
            PG8_BAR; PG8_WAIT_L(0); PG8_MMA(1, 0, At, B0); PG8_BAR; PG8_SCHED;
            PG8_STAGE(PG8_SB(1, 1), b3 + hstep, voffB);
            PG8_WAIT_V(6); PG8_BAR; PG8_MMA(1, 1, At, B1); PG8_BAR;
            }
        }
        if constexpr (ALIGN_EPI) { if (wr == 0) PG8_BAR; }
        if constexpr (!Epi::AFTER_DRAIN) { E(acc, cur, wr, wc, fr, fq); S.done(cur); }
        if (!has_next) break;
#pragma unroll
        for (int a = 0; a < 2; ++a)
#pragma unroll
            for (int b = 0; b < 2; ++b)
#pragma unroll
                for (int m = 0; m < 4; ++m)
#pragma unroll
                    for (int n = 0; n < 2; ++n) acc[a][b][m][n] = (f32x4){0.f, 0.f, 0.f, 0.f};
        cur = nxt; cA = nA; cB = nB; ++ui;
        if constexpr (ALIGN_EPI) { if (wr == 1) PG8_BAR; }
    }
    PG8_WAIT_V(0);
    if constexpr (!ALIGN_EPI) { if (wr == 0) PG8_BAR; }
    PG8_BAR;
    if constexpr (Epi::AFTER_DRAIN) { E.fused(acc, cur, wr, wc, fr, fq, lds, wid, lane); S.done(cur); }
#undef PG8_SA
#undef PG8_SB
#undef PG8_STAGE
#undef PG8_LDA
#undef PG8_LDB
#undef PG8_MMA
#undef PG8_WAIT_V
#undef PG8_WAIT_L
#undef PG8_BAR
#undef PG8_SCHED
}
}

#define DI __device__ __forceinline__
#define LAS __attribute__((address_space(3)))
typedef unsigned short bf16_t;
typedef short bf16x8 __attribute__((ext_vector_type(8)));
typedef short s16x4 __attribute__((ext_vector_type(4)));
typedef float f32x4 __attribute__((ext_vector_type(4)));
typedef float f32x16 __attribute__((ext_vector_type(16)));
typedef unsigned u32x4 __attribute__((ext_vector_type(4)));
typedef unsigned u32x2 __attribute__((ext_vector_type(2)));

constexpr int DM = 1024, SEQ = 16384, NTP = 32768, NTS = 256, MTOT = 33024, DFF = 2816, NPROJ = 3328, NSEQ = 18, NMOD = 9216;
constexpr float EPS = 1e-6f, LOG2E = 1.4426950408889634f, C2 = 0.125f * LOG2E, NEGBIG = -1e30f;
constexpr int PC_QA = 0, PC_KA = 256, PC_VA = 512, PC_QB = 768, PC_KB = 896, PC_VB = 1024, PC_RB = 1280, PC_QC = 1536, PC_KC = 2048, PC_VC = 2560;
constexpr size_t O_FKP = 33816576, O_FVP = O_FKP + 16777216, O_FLP = O_FVP + 16777216, O_GSP = O_FLP + 262144, O_DKP = O_GSP + 32768, O_DVP = O_DKP + 33554432,
                 O_FKS = O_DVP + 33554432, O_FVS = O_FKS + 131072, O_FLS = O_FVS + 131072, O_GSS = O_FLS + 2048, O_DKS = O_GSS + 262144, O_DVS = O_DKS + 262144, O_END = O_DVS + 262144;
static_assert(O_END == 135825408, "output map");
constexpr size_t SZ_WFI1 = (size_t)5632 * 1024 * 2, SZ_WFO1 = (size_t)1024 * 2816 * 2, SZ_WIN1 = (size_t)3328 * 1024 * 2, SZ_WOUT1 = (size_t)1024 * 1024 * 2;
constexpr size_t WS_WFI = 0, WS_WFO = WS_WFI + 4 * SZ_WFI1, WS_WIN = WS_WFO + 4 * SZ_WFO1, WS_WOUT = WS_WIN + 2 * SZ_WIN1, WS_MOD = WS_WOUT + 2 * SZ_WOUT1;
constexpr size_t WS_LAM = WS_MOD + (size_t)2 * NSEQ * NMOD * 4, WS_H = WS_LAM + 1024, WS_UP = WS_H + (size_t)MTOT * 1024 * 2, WS_Y = WS_UP + (size_t)MTOT * NPROJ * 2;
constexpr size_t WS_PF = WS_Y, WS_CLOC = WS_PF + (size_t)MTOT * 32 * 4, WS_CTOT = WS_CLOC + (size_t)NTP * 4 * 4, WS_CB = WS_CTOT + 4096, WS_GU = WS_CB + (size_t)NTP * 128 * 4;
constexpr size_t WS_GS = WS_GU + (size_t)2048 * 2048 * 4, WS_GDEC = WS_GS + (size_t)2048 * 2048 * 4, WS_OSCR = WS_GDEC + (size_t)2048 * 32 * 4, WS_MIXEND = WS_OSCR + (size_t)2 * NTP * 512 * 2;
constexpr size_t WS_YS = WS_Y + (size_t)MTOT * 1024 * 4;
constexpr size_t WS_BAR = WS_YS + (size_t)8 * NTS * 1024 * 4;
constexpr size_t WS_END = WS_BAR + 16384;
static_assert(WS_MIXEND <= WS_YS && (WS_H % 256) == 0 && (WS_UP % 256) == 0 && (WS_Y % 256) == 0, "ws map");
constexpr int LDS_BYTES = 147456, LDS_XBST = 147456 - 112;

struct Args { const float* in[23]; float* out; unsigned char* ws; int nph; unsigned char plist[60]; };
static_assert(sizeof(Args) == 264, "Args has no padding");
enum { I_XP = 0, I_XS, I_CP, I_CS, I_CFK, I_CFV, I_CFL, I_SG, I_CDK, I_CDV, I_WADA, I_BADA, I_GN, I_WFI, I_WFO, I_WIN, I_BF, I_WGU, I_BGU, I_GGLA, I_GDIFF, I_LAMP, I_WOUT };

DI const float* ain_(const Args& a, int i) { asm volatile("" : "+s"(i)); return a.in[i]; }
#define AIN(a, i) ain_(a, i)
DI unsigned char* wsp_(const Args& a) { unsigned char* p = a.ws; asm volatile("" : "+s"(p)); return p; }
DI float* outp_(const Args& a) { float* p = a.out; asm volatile("" : "+s"(p)); return p; }
#define WSP(a) wsp_(a)
#define OUTP(a) outp_(a)
DI LAS unsigned char* lnd(LAS unsigned char* p) { asm volatile("" : "+s"(p)); return p; }
DI float one_minus_lam_init(int l) { const unsigned bits = (l == 0) ? 0x3f4ccccdu : 0x3f24fd5cu; return __uint_as_float(bits); }
DI float bf2f(bf16_t b) { return __uint_as_float((unsigned)b << 16); }
DI unsigned pk2(float lo, float hi) { return pg8::cvt_pk_bf16(lo, hi); }
DI float silu_f(float x) { return x / (1.f + __expf(-x)); }
DI float silu_fast(float x) { return x * __builtin_amdgcn_rcpf(1.f + __expf(-x)); }
DI float logsig(float x) { return fminf(x, 0.f) - log1pf(__expf(-fabsf(x))); }
DI float wave_sum(float v) {
#pragma unroll
    for (int o = 1; o < 64; o <<= 1) v += __shfl_xor(v, o);
    return v;
}
DI float wave_max(float v) {
#pragma unroll
    for (int o = 1; o < 64; o <<= 1) v = fmaxf(v, __shfl_xor(v, o));
    return v;
}
DI float half_max(float v) { auto rr = __builtin_amdgcn_permlane32_swap(__float_as_uint(v), __float_as_uint(v), false, false); return fmaxf(__uint_as_float(rr[0]), __uint_as_float(rr[1])); }
DI float half_sum(float v) { auto rr = __builtin_amdgcn_permlane32_swap(__float_as_uint(v), __float_as_uint(v), false, false); return __uint_as_float(rr[0]) + __uint_as_float(rr[1]); }
DI int seq_of(int m) { return m < NTP ? (m >> 14) : 2 + ((m - NTP) >> 4); }
DI int crow(int r, int hi) { return (r & 3) + 8 * (r >> 2) + 4 * hi; }

struct EpiSwiglu {
    static constexpr bool PERM = true, AFTER_DRAIN = false;
    bf16_t* U;
    DI void operator()(const pg8::f32x4 (&acc)[2][2][4][2], const pg8::Unit& u, int wr, int wc, int fr, int fq) const {
        const int row0 = u.pm * 256 + wr * 64 + fr, col0 = u.pn * 128 + wc * 32 + 8 * fq;
#pragma unroll
        for (int ai = 0; ai < 2; ++ai)
#pragma unroll
            for (int m = 0; m < 4; ++m) {
                const pg8::f32x4 g0 = acc[ai][0][m][0], g1 = acc[ai][0][m][1], u0 = acc[ai][1][m][0], u1 = acc[ai][1][m][1];
                u32x4 w;
                w.x = pk2(silu_fast(g0[0]) * u0[0], silu_fast(g0[1]) * u0[1]); w.y = pk2(silu_fast(g0[2]) * u0[2], silu_fast(g0[3]) * u0[3]);
                w.z = pk2(silu_fast(g1[0]) * u1[0], silu_fast(g1[1]) * u1[1]); w.w = pk2(silu_fast(g1[2]) * u1[2], silu_fast(g1[3]) * u1[3]);
                *(u32x4*)(U + (size_t)(row0 + ai * 128 + m * 16) * DFF + col0) = w;
            }
    }
};
struct EpiF32 {
    static constexpr bool PERM = true, AFTER_DRAIN = false;
    bf16_t* Y;
    DI void operator()(const pg8::f32x4 (&acc)[2][2][4][2], const pg8::Unit& u, int wr, int wc, int fr, int fq) const {
        const int row0 = u.pm * 256 + wr * 64 + fr, col0 = u.pn * 256 + wc * 32 + 8 * fq;
#pragma unroll
        for (int ai = 0; ai < 2; ++ai)
#pragma unroll
            for (int m = 0; m < 4; ++m) {
                bf16_t* rp = Y + (size_t)(row0 + ai * 128 + m * 16) * DM + col0;
#pragma unroll
                for (int bj = 0; bj < 2; ++bj) { const pg8::f32x4 v0 = acc[ai][bj][m][0], v1 = acc[ai][bj][m][1];
                    u32x4 w; w.x = pk2(v0[0], v0[1]); w.y = pk2(v0[2], v0[3]); w.z = pk2(v1[0], v1[1]); w.w = pk2(v1[2], v1[3]);
                    *(u32x4*)(rp + bj * 128) = w; }
            }
    }
};
struct EpiProj {
    static constexpr bool PERM = true, AFTER_DRAIN = false;
    bf16_t* P; float* out; float* PF; int l;
    DI void operator()(const pg8::f32x4 (&acc)[2][2][4][2], const pg8::Unit& u, int wr, int wc, int fr, int fq) const {
        const int pn = u.pn; const bool samp = (u.pm == 128);
        float* dst = nullptr; int W = 0, cbase = 0;
        if (pn == 1) { dst = out + (samp ? O_FKS : O_FKP); W = 256; }
        else if (pn == 2) { dst = out + (samp ? O_FVS : O_FVP); W = 256; }
        else if (pn == 8 || pn == 9) { dst = out + (samp ? O_DKS : O_DKP); W = 512; cbase = (pn - 8) * 256; }
        else if (pn == 10 || pn == 11) { dst = out + (samp ? O_DVS : O_DVP); W = 512; cbase = (pn - 10) * 256; }
        const size_t lrows = samp ? (size_t)l * NTS : (size_t)l * NTP; const int rbase = samp ? NTP : 0;
#pragma unroll
        for (int ai = 0; ai < 2; ++ai)
#pragma unroll
            for (int m = 0; m < 4; ++m) {
                const int row = u.pm * 256 + ai * 128 + wr * 64 + m * 16 + fr;
#pragma unroll
                for (int bj = 0; bj < 2; ++bj) {
                    const int ct = bj * 128 + wc * 32 + 8 * fq;
                    const pg8::f32x4 v0 = acc[ai][bj][m][0], v1 = acc[ai][bj][m][1];
                    u32x4 w; w.x = pk2(v0[0], v0[1]); w.y = pk2(v0[2], v0[3]); w.z = pk2(v1[0], v1[1]); w.w = pk2(v1[2], v1[3]);
                    *(u32x4*)(P + (size_t)row * NPROJ + pn * 256 + ct) = w;
                    if (dst) { float* d = dst + (lrows + (size_t)(row - rbase)) * W + cbase + ct; *(f32x4*)d = v0; *(f32x4*)(d + 4) = v1; }
                    if (pn == 12 && ct < 32) { float* d = PF + (size_t)row * 32 + ct; *(f32x4*)d = v0; *(f32x4*)(d + 4) = v1; }
                }
            }
    }
};

DI int srccol(int mode, int d) {
    if (mode == 0) return d;
    if (mode == 1) { const int t = d >> 8, w = d & 255; return w < 128 ? t * 128 + w : DFF + t * 128 + (w - 128); }
    if (d < 768) return d;
    if (d < 1280) return d + 4;
    if (d < 3072) return d + 20;
    if (d < 3076) return 768 + (d - 3072);
    if (d < 3092) return 1284 + (d - 3076);
    return -1;
}
DI void tr_item(const float* W, int K, int Nsrc, bf16_t* WT, int mode, LAS float* scr, int kb, int db, int lane) {
    const int k0 = 64 * kb, d0 = 32 * db, sc = srccol(mode, d0 + (lane & 31));
#pragma unroll 16
    for (int i = 0; i < 32; ++i) { const int kk = 2 * i + (lane >> 5); scr[kk * 33 + (lane & 31)] = sc >= 0 ? W[(size_t)(k0 + kk) * Nsrc + sc] : 0.f; }
    asm volatile("s_waitcnt lgkmcnt(0)" ::: "memory");
    const int c = lane & 7;
#pragma unroll
    for (int j = 0; j < 4; ++j) { const int n = (lane >> 3) + 8 * j; const LAS float* s = scr + (8 * c) * 33 + n;
        u32x4 o; o.x = pk2(s[0 * 33], s[1 * 33]); o.y = pk2(s[2 * 33], s[3 * 33]); o.z = pk2(s[4 * 33], s[5 * 33]); o.w = pk2(s[6 * 33], s[7 * 33]);
        *(u32x4*)(WT + (size_t)(d0 + n) * K + k0 + 8 * c) = o; }
    asm volatile("s_waitcnt lgkmcnt(0)" ::: "memory");
}
constexpr int TR_I_FI = 16 * 176, TR_I_FO = 44 * 32, TR_I_IN = 16 * 104, TR_I_OUT = 16 * 32;
constexpr int TR_ITEMS_PER_LAYER = 2 * TR_I_FI + 2 * TR_I_FO + TR_I_IN + TR_I_OUT;
DI void tr_layer_item(const Args& a, LAS unsigned char* lds, int layer, int r, int wave, int lane) {
    LAS float* scr = (LAS float*)(lds) + wave * (64 * 33); unsigned char* ws = WSP(a);
    if (r < 2 * TR_I_FI) { const int mi = layer * 2 + r / TR_I_FI, q = r % TR_I_FI; tr_item(AIN(a, I_WFI) + (size_t)mi * 1024 * 5632, 1024, 5632, (bf16_t*)(ws + WS_WFI + mi * SZ_WFI1), 1, scr, q / 176, q % 176, lane); return; }
    r -= 2 * TR_I_FI;
    if (r < 2 * TR_I_FO) { const int mi = layer * 2 + r / TR_I_FO, q = r % TR_I_FO; tr_item(AIN(a, I_WFO) + (size_t)mi * 2816 * 1024, 2816, 1024, (bf16_t*)(ws + WS_WFO + mi * SZ_WFO1), 0, scr, q / 32, q % 32, lane); return; }
    r -= 2 * TR_I_FO;
    if (r < TR_I_IN) { tr_item(AIN(a, I_WIN) + (size_t)layer * 1024 * 3092, 1024, 3092, (bf16_t*)(ws + WS_WIN + layer * SZ_WIN1), 2, scr, r / 104, r % 104, lane); return; }
    r -= TR_I_IN;
    tr_item(AIN(a, I_WOUT) + (size_t)layer * 1024 * 1024, 1024, 1024, (bf16_t*)(ws + WS_WOUT + layer * SZ_WOUT1), 0, scr, r / 32, r % 32, lane);
}
DI void phase_prologue(const Args& a, LAS unsigned char* lds) {
    const int tid = lt_tid(), lane = tid & 63, wave = tid >> 6;
    unsigned char* ws = WSP(a);
    {
        LAS float* sc = (LAS float*)lds; LAS float* red = sc + NSEQ * 1024;
        bool have = false;
        for (int item = blockIdx.x; item < 576; item += gridDim.x) {
            if (!have) {
                for (int i = tid; i < NSEQ * 1024; i += 512) { const int s = i >> 10, k = i & 1023; const float c = s < 2 ? AIN(a, I_CP)[s * 1024 + k] : AIN(a, I_CS)[(s - 2) * 1024 + k]; sc[i] = silu_f(c); }
                have = true; __syncthreads();
            }
            const int l = item / 288, n0 = (item % 288) * 32, c4 = tid & 7, kg = tid >> 3;
            f32x4 acc[NSEQ];
#pragma unroll
            for (int s = 0; s < NSEQ; ++s) acc[s] = (f32x4){0.f, 0.f, 0.f, 0.f};
            const float* wp = AIN(a, I_WADA) + ((size_t)l * 1024 + kg * 16) * NMOD + n0 + 4 * c4;
#pragma unroll 8
            for (int k = 0; k < 16; ++k) { const f32x4 w = *(const f32x4*)(wp + (size_t)k * NMOD);
#pragma unroll
                for (int s = 0; s < NSEQ; ++s) acc[s] = acc[s] + w * sc[s * 1024 + kg * 16 + k]; }
#pragma unroll
            for (int s = 0; s < NSEQ; ++s)
#pragma unroll
                for (int c = 0; c < 4; ++c) { float v = acc[s][c]; v += __shfl_xor(v, 8); v += __shfl_xor(v, 16); v += __shfl_xor(v, 32); acc[s][c] = v; }
            if ((tid & 63) < 8) {
#pragma unroll
                for (int s = 0; s < NSEQ; ++s) *(LAS f32x4*)(red + ((tid >> 6) * NSEQ + s) * 32 + 4 * c4) = acc[s]; }
            __syncthreads();
            float* MOD = (float*)(ws + WS_MOD);
            for (int i = tid; i < NSEQ * 32; i += 512) { const int s = i >> 5, c = i & 31; float v = AIN(a, I_BADA)[l * NMOD + n0 + c];
#pragma unroll
                for (int g = 0; g < 8; ++g) v += red[(g * NSEQ + s) * 32 + c];
                MOD[((size_t)l * NSEQ + s) * NMOD + n0 + c] = v; }
            __syncthreads();
        }
        __syncthreads();
    }
    if (blockIdx.x == 0 && tid < 2) { const float* lp = AIN(a, I_LAMP) + tid * 256; float s0 = 0.f, s1 = 0.f;
        for (int i = 0; i < 64; ++i) { s0 += lp[i] * lp[64 + i]; s1 += lp[128 + i] * lp[192 + i]; }
        const float lam_init = 0.8f - 0.6f * expf(-0.3f * (float)tid);
        ((float*)(ws + WS_LAM))[tid] = expf(s0) - expf(s1) + lam_init; }
    if (blockIdx.x == 0 && tid >= 64 && tid < 64 + 112) ((unsigned*)(ws + WS_LAM))[16 + tid - 64] = 0u;
    const int gw = blockIdx.x * 8 + wave, NGW = gridDim.x * 8;
    for (int it = gw; it < 2 * TR_ITEMS_PER_LAYER; it += NGW) tr_layer_item(a, lds, it >= TR_ITEMS_PER_LAYER ? 1 : 0, it % TR_ITEMS_PER_LAYER, wave, lane);
}

struct RowVecs { f32x4 gpo[4], gpr[4], m2[4], m0[4], m1[4]; int cur_sq; };
DI void rows_load(const Args& a, int m, bool first, bool post, int lane, f32x4 (&x)[4], u32x2 (&y)[4]) {
    const float* xs = first ? (m < NTP ? AIN(a, I_XP) + (size_t)m * DM : AIN(a, I_XS) + (size_t)(m - NTP) * DM) : OUTP(a) + (size_t)m * DM;
#pragma unroll
    for (int j = 0; j < 4; ++j) x[j] = *(const f32x4*)(xs + 4 * lane + 256 * j);
    if (post) { const bf16_t* yr = (const bf16_t*)(WSP(a) + WS_Y) + (size_t)m * DM;
#pragma unroll
        for (int j = 0; j < 4; ++j) y[j] = *(const u32x2*)(yr + 4 * lane + 256 * j); }
}
DI void rows_process(const Args& a, int m, int l, int post_s, float res_w, int pre_s, int pre_l, int lane, f32x4 (&x)[4], const u32x2 (&yw)[4], RowVecs& V) {
    const int sq = seq_of(m);
    if (sq != V.cur_sq) { V.cur_sq = sq; const float* MOD = (const float*)(WSP(a) + WS_MOD);
        if (post_s >= 0) { const float* p2 = MOD + ((size_t)l * NSEQ + sq) * NMOD + (post_s * 3 + 2) * DM;
#pragma unroll
            for (int j = 0; j < 4; ++j) V.m2[j] = *(const f32x4*)(p2 + 4 * lane + 256 * j); }
        if (pre_s >= 0) { const float* mb = MOD + ((size_t)pre_l * NSEQ + sq) * NMOD + (pre_s * 3) * DM;
#pragma unroll
            for (int j = 0; j < 4; ++j) { V.m0[j] = *(const f32x4*)(mb + 4 * lane + 256 * j); V.m1[j] = *(const f32x4*)(mb + DM + 4 * lane + 256 * j); } } }
    if (post_s >= 0) {
        f32x4 y[4]; float ss = 0.f;
#pragma unroll
        for (int j = 0; j < 4; ++j) { y[j] = (f32x4){__uint_as_float(yw[j].x << 16), __uint_as_float(yw[j].x & 0xffff0000u), __uint_as_float(yw[j].y << 16), __uint_as_float(yw[j].y & 0xffff0000u)};
            if (m >= NTP) { const float* ys = (const float*)(WSP(a) + WS_YS) + (size_t)(m - NTP) * DM + 4 * lane + 256 * j; y[j] = *(const f32x4*)ys;
#pragma unroll
                for (int ks = 1; ks < 8; ++ks) y[j] = y[j] + *(const f32x4*)(ys + (size_t)ks * NTS * DM); }
            ss += (y[j].x * y[j].x + y[j].y * y[j].y) + (y[j].z * y[j].z + y[j].w * y[j].w); }
        const float ry = rsqrtf(wave_sum(ss) * (1.f / DM) + EPS) * res_w;
#pragma unroll
        for (int j = 0; j < 4; ++j) x[j] = x[j] + V.m2[j] * (y[j] * ry * V.gpo[j]);
        float* xd = OUTP(a) + (size_t)m * DM;
#pragma unroll
        for (int j = 0; j < 4; ++j) *(f32x4*)(xd + 4 * lane + 256 * j) = x[j];
    }
    if (pre_s >= 0) {
        float ss = 0.f;
#pragma unroll
        for (int j = 0; j < 4; ++j) ss += (x[j].x * x[j].x + x[j].y * x[j].y) + (x[j].z * x[j].z + x[j].w * x[j].w);
        const float rx = rsqrtf(wave_sum(ss) * (1.f / DM) + EPS);
        bf16_t* hr = (bf16_t*)(WSP(a) + WS_H) + (size_t)m * DM;
#pragma unroll
        for (int j = 0; j < 4; ++j) { const f32x4 hv = (x[j] * rx * V.gpr[j]) * (V.m1[j] + 1.f) + V.m0[j]; u32x2 w; w.x = pk2(hv.x, hv.y); w.y = pk2(hv.z, hv.w); *(u32x2*)(hr + 4 * lane + 256 * j) = w; }
    }
}
DI void phase_rows(const Args& a, int l, int post_s, float res_w, int pre_s, int pre_l, bool first) {
    const int tid = lt_tid(), lane = tid & 63, wave = tid >> 6;
    const int gw = blockIdx.x * 8 + wave, NGW = gridDim.x * 8;
    RowVecs V; V.cur_sq = -1;
#pragma unroll
    for (int j = 0; j < 4; ++j) { V.gpo[j] = V.gpr[j] = V.m2[j] = V.m0[j] = V.m1[j] = (f32x4){0.f, 0.f, 0.f, 0.f}; }
    if (post_s >= 0) { const float* g = AIN(a, I_GN) + (size_t)(l * 6 + 2 * post_s + 1) * DM;
#pragma unroll
        for (int j = 0; j < 4; ++j) V.gpo[j] = *(const f32x4*)(g + 4 * lane + 256 * j); }
    if (pre_s >= 0) { const float* g = AIN(a, I_GN) + (size_t)(pre_l * 6 + 2 * pre_s) * DM;
#pragma unroll
        for (int j = 0; j < 4; ++j) V.gpr[j] = *(const f32x4*)(g + 4 * lane + 256 * j); }
    constexpr int NR = 4;
    for (int m0 = gw; m0 < MTOT; m0 += NR * NGW) {
        f32x4 x[NR][4]; u32x2 y[NR][4];
#pragma unroll
        for (int r = 0; r < NR; ++r)
#pragma unroll
            for (int j = 0; j < 4; ++j) { y[r][j] = (u32x2){0u, 0u}; x[r][j] = (f32x4){0.f, 0.f, 0.f, 0.f}; }
#pragma unroll
        for (int r = 0; r < NR; ++r) if (m0 + r * NGW < MTOT) rows_load(a, m0 + r * NGW, first, post_s >= 0, lane, x[r], y[r]);
#pragma unroll
        for (int r = 0; r < NR; ++r) if (m0 + r * NGW < MTOT) rows_process(a, m0 + r * NGW, l, post_s, res_w, pre_s, pre_l, lane, x[r], y[r], V);
    }
}
#define XB_TMO      128
#define XB_XCNT(j)  (256  + 64 * (j))
#define XB_XSUB(j)  (1280 + 64 * (j))
#define XB_XGEN(j)  (2304 + 64 * (j))
#define XB_TOP      3328
#define XB_TOPGEN   3392
#define XCD_BAR_WORDS 3456
#define XB_SPIN_CAP (1u << 18)

__device__ __forceinline__ unsigned xb_ld(unsigned* p)              { return __hip_atomic_load(p, __ATOMIC_RELAXED, __HIP_MEMORY_SCOPE_AGENT); }
__device__ __forceinline__ unsigned xb_add(unsigned* p, unsigned v) { return __hip_atomic_fetch_add(p, v, __ATOMIC_RELAXED, __HIP_MEMORY_SCOPE_AGENT); }
__device__ __forceinline__ unsigned xb_xcc_id() { return (unsigned)__builtin_amdgcn_s_getreg((3 << 11) | 20) & 0xFu; }
#define XB_SPIN(cond, bar) do { unsigned _sp = 0; while (cond) { __builtin_amdgcn_s_sleep(1); \
    if ((++_sp & 255u) == 0u) { if (xb_ld(&(bar)[XB_TMO])) break; if (_sp > XB_SPIN_CAP) { atomicAdd(&(bar)[XB_TMO], 1u); break; } } } } while (0)

struct XcdBarrier {
    unsigned* bar; unsigned x;
    volatile LAS unsigned* st;
};

__device__ __forceinline__ XcdBarrier xcd_barrier_post(unsigned* bar, volatile LAS unsigned* st) {
    XcdBarrier b; b.bar = bar; b.x = xb_xcc_id(); b.st = st;
    if (lt_tid() == 0) (void)xb_add(&bar[XB_XCNT(b.x)], 1u);
    return b;
}
__device__ __forceinline__ void xcd_barrier_complete(unsigned* bar, unsigned x, unsigned& nloc, unsigned& nx) {
    const unsigned G = gridDim.x * gridDim.y * gridDim.z;
    unsigned sum, cnt, mine, sp = 0u;
    for (;;) {
        sum = 0u; cnt = 0u; mine = 0u;
#pragma unroll
        for (unsigned j = 0; j < 16; ++j) { const unsigned c = xb_ld(&bar[XB_XCNT(j)]); sum += c; cnt += (c > 0u) ? 1u : 0u; mine = (j == x) ? c : mine; }
        if (sum == G) break;
        __builtin_amdgcn_s_sleep(1);
        if ((++sp & 255u) == 0u) { if (xb_ld(&bar[XB_TMO])) break; if (sp > XB_SPIN_CAP) { atomicAdd(&bar[XB_TMO], 1u); break; } }
    }
    nloc = mine > 0u ? mine : 1u; nx = cnt > 0u ? cnt : 1u;
}

__device__ __forceinline__ void xcd_barrier(const XcdBarrier& b) {
    asm volatile("s_waitcnt vmcnt(0)" ::: "memory");
    __syncthreads();
    if (lt_tid() == 0) {
        unsigned* bar = b.bar;
        __builtin_amdgcn_s_waitcnt(0);
        unsigned nloc = b.st[0], nx = b.st[1];
        if (nloc == 0u) { xcd_barrier_complete(bar, b.x, nloc, nx); b.st[0] = nloc; b.st[1] = nx; }
        const unsigned old = xb_add(&bar[XB_XSUB(b.x)], 1u);
        const unsigned gen = old / nloc;
        if (old + 1u == (gen + 1u) * nloc) {
            __builtin_amdgcn_fence(__ATOMIC_RELEASE, "agent");
            asm volatile("s_waitcnt vmcnt(0)" ::: "memory");
            const unsigned og = xb_add(&bar[XB_TOP], 1u);
            const unsigned tg = og / nx;
            if (og + 1u == (tg + 1u) * nx) xb_add(&bar[XB_TOPGEN], 1u);
            else XB_SPIN(xb_ld(&bar[XB_TOPGEN]) == tg, bar);
            __builtin_amdgcn_fence(__ATOMIC_ACQUIRE, "agent");
            xb_add(&bar[XB_XGEN(b.x)], 1u);
            asm volatile("s_waitcnt vmcnt(0)" ::: "memory");
        } else {
            XB_SPIN(xb_ld(&bar[XB_XGEN(b.x)]) == gen, bar);
            __builtin_amdgcn_fence(__ATOMIC_ACQUIRE, "agent");
            asm volatile("s_waitcnt vmcnt(0)" ::: "memory");
        }
    }
    __syncthreads();
}

constexpr int KP = 144;
constexpr int AT_K = 0, AT_V = 64 * KP, AT_B = AT_V + 64 * 272, AT_BUF = AT_B + 256;
static_assert(4 * AT_BUF + 64 <= LDS_BYTES - 128 && (AT_BUF % 16) == 0, "attention LDS");
typedef short v4i16_t __attribute__((ext_vector_type(4)));
DI s16x4 vtr(const LAS unsigned char* p) { return __builtin_bit_cast(s16x4, __builtin_amdgcn_ds_read_tr16_b64_v4i16((LAS v4i16_t*)p)); }

template <int DV, bool FOX, int HH>
DI void attn_pass(LAS unsigned char* lds, const bf16_t* __restrict__ P, size_t rowbase, int q0, int qcol, int kcol, int vcol,
                  const float* __restrict__ cloc, const float* __restrict__ ctot_b, int h, float sb, f32x16 (&O)[DV / 32], float& l_out) {
    constexpr float slope_l2 = (HH == 0 ? 0.25f : HH == 1 ? 0.0625f : HH == 2 ? 0.015625f : 0.00390625f) * LOG2E;
    constexpr int VP = DV * 2 + 16, NVR = DV / 64;
    lds = lnd(lds);
    const int tid = lt_tid(), lane = tid & 63, w = __builtin_amdgcn_readfirstlane(tid >> 6), r32 = lane & 31, hi = lane >> 5;
    const int qrow = q0 + 32 * w + r32;
    bf16x8 qf[4];
    { const bf16_t* qp = P + (rowbase + qrow) * NPROJ + qcol + 8 * hi;
#pragma unroll
      for (int d0 = 0; d0 < 4; ++d0) qf[d0] = *(const bf16x8*)(qp + 16 * d0); }
    const int tmax_wg = (q0 >> 6) + 3, tmax_w = (q0 >> 6) + (w >> 1);
    float mrun = NEGBIG, lrun = 0.f;
    float ubase;
    { float qs = 0.f;
#pragma unroll
      for (int d0 = 0; d0 < 4; ++d0)
#pragma unroll
          for (int j = 0; j < 8; ++j) { const float v = bf2f((bf16_t)qf[d0][j]); qs += v * v; }
      qs = half_sum(qs); ubase = sb * wave_max(sqrtf(qs)) * 1.01f + 30.1f;
      ubase = __uint_as_float(__builtin_amdgcn_readfirstlane(__float_as_uint(ubase))); }
    bool done = false;
    const float hterm = FOX ? 0.f : slope_l2 * 4.f * (float)hi;
    LAS int* flags = (LAS int*)(lds + 4 * AT_BUF);
#pragma unroll
    for (int db = 0; db < DV / 32; ++db)
#pragma unroll
        for (int r = 0; r < 16; ++r) O[db][r] = 0.f;
    const int srow = tid >> 3, sch = tid & 7;
    u32x4 kregA, vregA[NVR], kregB, vregB[NVR]; float bregA = 0.f, bregB = 0.f; float Drun = 0.f; int kt_cur = q0 >> 8;
#define AT_ISSUE(S, t) do { const bf16_t* rp = P + (rowbase + 64 * (t) + srow) * NPROJ; \
        kreg##S = *(const u32x4*)(rp + kcol + 8 * sch); \
        _Pragma("unroll") for (int i_ = 0; i_ < NVR; ++i_) vreg##S[i_] = *(const u32x4*)(rp + vcol + 8 * (sch + 8 * i_)); \
        if (FOX) { const int kt_ = (t) >> 2; if (kt_ != kt_cur) { Drun += ctot_b[kt_ * 4 + h]; kt_cur = kt_; } \
                   if (tid < 64) breg##S = (Drun - cloc[(rowbase + 64 * (t) + tid) * 4 + h]) * LOG2E; } } while (0)
    AT_ISSUE(A, tmax_wg); AT_ISSUE(B, tmax_wg - 1);
    int it = 0, t = tmax_wg;
    for (;;) {
      {
        const int pr = it >> 1;
        LAS unsigned char* bufA = lds + ((pr & 1) * 2) * AT_BUF; LAS unsigned char* bufB = bufA + AT_BUF;
        *(LAS u32x4*)(bufA + AT_K + srow * KP + sch * 16) = kregA;
#pragma unroll
        for (int i = 0; i < NVR; ++i) *(LAS u32x4*)(bufA + AT_V + srow * VP + (sch + 8 * i) * 16) = vregA[i];
        if (FOX) { if (tid < 64) *(LAS float*)(bufA + AT_B + tid * 4) = bregA; }
        *(LAS u32x4*)(bufB + AT_K + srow * KP + sch * 16) = kregB;
#pragma unroll
        for (int i = 0; i < NVR; ++i) *(LAS u32x4*)(bufB + AT_V + srow * VP + (sch + 8 * i) * 16) = vregB[i];
        if (FOX) { if (tid < 64) *(LAS float*)(bufB + AT_B + tid * 4) = bregB; }
        asm volatile("s_waitcnt lgkmcnt(0)" ::: "memory"); __builtin_amdgcn_s_barrier(); asm volatile("" ::: "memory");
        if (pr > 0) { const LAS int* fl = flags + ((pr - 1) & 1) * 8; int all = 1;
#pragma unroll
            for (int i = 0; i < 8; ++i) all &= fl[i];
            if (all) break; }
        if (t > 1) AT_ISSUE(A, t - 2);
        if (t > 2) AT_ISSUE(B, t - 3);
        { LAS unsigned char* buf = bufA;
        if (t <= tmax_w && !done) {
            const float bmax = FOX ? ((const LAS float*)(buf + AT_B))[63] : slope_l2 * (float)(64 * t + 63 - q0);
            if (__all(ubase + bmax < mrun)) done = true;
        }
        if (t <= tmax_w && !done) {
            const float base_t = FOX ? 0.f : slope_l2 * (float)(64 * t - q0); float c32 = 0.f, hadd = 0.f;
            f32x16 s0, s1;
#pragma unroll
            for (int r = 0; r < 16; ++r) { s0[r] = 0.f; s1[r] = 0.f; }
            const LAS unsigned char* kb = buf + AT_K + r32 * KP + hi * 16;
            const LAS unsigned char* vb = buf + AT_V + (4 * hi + ((lane & 15) >> 2)) * VP + (16 * ((lane >> 4) & 1) + 4 * (lane & 3)) * 2;
            bf16x8 kf[8];
#pragma unroll
            for (int d0 = 0; d0 < 4; ++d0) { kf[2 * d0] = *(const LAS bf16x8*)(kb + d0 * 32); kf[2 * d0 + 1] = *(const LAS bf16x8*)(kb + 32 * KP + d0 * 32); }
            __builtin_amdgcn_sched_barrier(0);
            __builtin_amdgcn_s_setprio(1);
#pragma unroll
            for (int d0 = 0; d0 < 4; ++d0) {
                s0 = __builtin_amdgcn_mfma_f32_32x32x16_bf16(kf[2 * d0], qf[d0], s0, 0, 0, 0);
                s1 = __builtin_amdgcn_mfma_f32_32x32x16_bf16(kf[2 * d0 + 1], qf[d0], s1, 0, 0, 0);
            }
            __builtin_amdgcn_s_setprio(0);
            s16x4 vfa[8], vfb[8];
#define AT_RDV(dst, db) do { _Pragma("unroll") for (int ks_ = 0; ks_ < 4; ++ks_) { dst[2 * ks_] = vtr(vb + (16 * ks_) * VP + (db) * 64); dst[2 * ks_ + 1] = vtr(vb + (16 * ks_ + 8) * VP + (db) * 64); } } while (0)
            if (FOX) {
                const LAS float* bb = (const LAS float*)(buf + AT_B);
#pragma unroll
                for (int g = 0; g < 4; ++g) { const f32x4 b0 = *(const LAS f32x4*)(bb + 8 * g + 4 * hi), b1 = *(const LAS f32x4*)(bb + 32 + 8 * g + 4 * hi);
#pragma unroll
                    for (int j = 0; j < 4; ++j) { s0[4 * g + j] = s0[4 * g + j] * C2 + b0[j]; s1[4 * g + j] = s1[4 * g + j] * C2 + b1[j]; } }
                if (t == tmax_w) { const int qil = 32 * (w & 1) + r32;
#pragma unroll
                    for (int r = 0; r < 16; ++r) { const int j0 = crow(r, hi); if (j0 > qil) s0[r] = NEGBIG; if (j0 + 32 > qil) s1[r] = NEGBIG; } }
            } else {
                if (t == tmax_w) { const int il = qrow - 64 * t;
#pragma unroll
                    for (int r = 0; r < 16; ++r) { const int j0 = crow(r, hi), j1 = j0 + 32;
                        s0[r] = s0[r] * C2 + slope_l2 * (float)(j0 > il ? 2 * il - j0 : j0); s1[r] = s1[r] * C2 + slope_l2 * (float)(j1 > il ? 2 * il - j1 : j1); }
                } else {
#pragma unroll
                    for (int r = 0; r < 16; ++r) { const float cc = slope_l2 * (float)crow(r, 0); s0[r] = s0[r] * C2 + cc; s1[r] = s1[r] * C2 + cc; }
                    c32 = 32.f * slope_l2; hadd = hterm;
                }
            }
            float mx0 = s0[0], mx1 = s1[0];
#pragma unroll
            for (int r = 1; r < 16; ++r) { mx0 = fmaxf(mx0, s0[r]); mx1 = fmaxf(mx1, s1[r]); }
            float mx = fmaxf(mx0, mx1 + c32) + hadd;
            mx = half_max(mx) + base_t;
            const float mnew = fmaxf(mrun, mx), msub = mnew - base_t - hadd, msub1 = msub - c32;
            if (__any(mnew > mrun)) { const float alpha = __builtin_amdgcn_exp2f(mrun - mnew); lrun *= alpha;
#pragma unroll
                for (int db = 0; db < DV / 32; ++db)
#pragma unroll
                    for (int r = 0; r < 16; ++r) O[db][r] *= alpha; }
            mrun = mnew;
#define AT_RDH(dst, dp, kh) do { _Pragma("unroll") for (int d_ = 0; d_ < 2; ++d_) _Pragma("unroll") for (int k_ = 0; k_ < 2; ++k_) { \
                dst[d_ * 4 + k_ * 2] = vtr(vb + (16 * (2 * (kh) + k_)) * VP + (2 * (dp) + d_) * 64); dst[d_ * 4 + k_ * 2 + 1] = vtr(vb + (16 * (2 * (kh) + k_) + 8) * VP + (2 * (dp) + d_) * 64); } } while (0)
#define AT_PVH(cur, dp, kh) do { _Pragma("unroll") for (int d_ = 0; d_ < 2; ++d_) _Pragma("unroll") for (int k_ = 0; k_ < 2; ++k_) { \
                const s16x4 lo_ = cur[d_ * 4 + k_ * 2], hi_ = cur[d_ * 4 + k_ * 2 + 1]; \
                const bf16x8 vf_ = (bf16x8){lo_[0], lo_[1], lo_[2], lo_[3], hi_[0], hi_[1], hi_[2], hi_[3]}; \
                O[2 * (dp) + d_] = __builtin_amdgcn_mfma_f32_32x32x16_bf16(vf_, __builtin_bit_cast(bf16x8, pw[2 * (kh) + k_]), O[2 * (dp) + d_], 0, 0, 0); } } while (0)
            __builtin_amdgcn_sched_barrier(0);
            AT_RDH(vfa, 0, 0);
            __builtin_amdgcn_sched_barrier(0);
            float ps = 0.f; u32x4 pw[4];
#pragma unroll
            for (int r = 0; r < 16; ++r) { s0[r] = __builtin_amdgcn_exp2f(s0[r] - msub); ps += s0[r]; }
#pragma unroll
            for (int i = 0; i < 4; ++i) { pw[0][i] = pk2(s0[2 * i], s0[2 * i + 1]); pw[1][i] = pk2(s0[8 + 2 * i], s0[8 + 2 * i + 1]); }
            __builtin_amdgcn_sched_barrier(0);
            if constexpr (DV == 128) AT_RDH(vfb, 1, 0); else AT_RDH(vfb, 0, 1);
            __builtin_amdgcn_sched_barrier(0);
            __builtin_amdgcn_s_setprio(1);
            AT_PVH(vfa, 0, 0);
            if constexpr (DV == 128) AT_PVH(vfb, 1, 0);
#pragma unroll
            for (int r = 0; r < 16; ++r) { s1[r] = __builtin_amdgcn_exp2f(s1[r] - msub1); ps += s1[r]; }
#pragma unroll
            for (int i = 0; i < 4; ++i) { pw[2][i] = pk2(s1[2 * i], s1[2 * i + 1]); pw[3][i] = pk2(s1[8 + 2 * i], s1[8 + 2 * i + 1]); }
#pragma unroll
            for (int i = 0; i < (DV == 128 ? 8 : 4); ++i) { __builtin_amdgcn_sched_group_barrier(0x008, 1, 0); __builtin_amdgcn_sched_group_barrier(0x402, (DV == 128 ? 7 : 14), 0); }
            __builtin_amdgcn_sched_barrier(0);
            if constexpr (DV == 128) {
                AT_RDH(vfa, 0, 1); AT_RDH(vfb, 1, 1); __builtin_amdgcn_sched_barrier(0);
                AT_PVH(vfa, 0, 1); AT_PVH(vfb, 1, 1);
            } else {
                AT_PVH(vfb, 0, 1);
            }
            __builtin_amdgcn_s_setprio(0);
            lrun += ps;
            __builtin_amdgcn_sched_barrier(0);
#undef AT_PVH
#undef AT_RDH
#undef AT_RDV
        }
        }
        --t; ++it;
        { LAS unsigned char* buf = bufB;
        if (t <= tmax_w && !done) {
            const float bmax = FOX ? ((const LAS float*)(buf + AT_B))[63] : slope_l2 * (float)(64 * t + 63 - q0);
            if (__all(ubase + bmax < mrun)) done = true;
        }
        if (t <= tmax_w && !done) {
            const float base_t = FOX ? 0.f : slope_l2 * (float)(64 * t - q0); float c32 = 0.f, hadd = 0.f;
            f32x16 s0, s1;
#pragma unroll
            for (int r = 0; r < 16; ++r) { s0[r] = 0.f; s1[r] = 0.f; }
            const LAS unsigned char* kb = buf + AT_K + r32 * KP + hi * 16;
            const LAS unsigned char* vb = buf + AT_V + (4 * hi + ((lane & 15) >> 2)) * VP + (16 * ((lane >> 4) & 1) + 4 * (lane & 3)) * 2;
            bf16x8 kf[8];
#pragma unroll
            for (int d0 = 0; d0 < 4; ++d0) { kf[2 * d0] = *(const LAS bf16x8*)(kb + d0 * 32); kf[2 * d0 + 1] = *(const LAS bf16x8*)(kb + 32 * KP + d0 * 32); }
            __builtin_amdgcn_sched_barrier(0);
            __builtin_amdgcn_s_setprio(1);
#pragma unroll
            for (int d0 = 0; d0 < 4; ++d0) {
                s0 = __builtin_amdgcn_mfma_f32_32x32x16_bf16(kf[2 * d0], qf[d0], s0, 0, 0, 0);
                s1 = __builtin_amdgcn_mfma_f32_32x32x16_bf16(kf[2 * d0 + 1], qf[d0], s1, 0, 0, 0);
            }
            __builtin_amdgcn_s_setprio(0);
            s16x4 vfa[8], vfb[8];
#define AT_RDV(dst, db) do { _Pragma("unroll") for (int ks_ = 0; ks_ < 4; ++ks_) { dst[2 * ks_] = vtr(vb + (16 * ks_) * VP + (db) * 64); dst[2 * ks_ + 1] = vtr(vb + (16 * ks_ + 8) * VP + (db) * 64); } } while (0)
            if (FOX) {
                const LAS float* bb = (const LAS float*)(buf + AT_B);
#pragma unroll
                for (int g = 0; g < 4; ++g) { const f32x4 b0 = *(const LAS f32x4*)(bb + 8 * g + 4 * hi), b1 = *(const LAS f32x4*)(bb + 32 + 8 * g + 4 * hi);
#pragma unroll
                    for (int j = 0; j < 4; ++j) { s0[4 * g + j] = s0[4 * g + j] * C2 + b0[j]; s1[4 * g + j] = s1[4 * g + j] * C2 + b1[j]; } }
                if (t == tmax_w) { const int qil = 32 * (w & 1) + r32;
#pragma unroll
                    for (int r = 0; r < 16; ++r) { const int j0 = crow(r, hi); if (j0 > qil) s0[r] = NEGBIG; if (j0 + 32 > qil) s1[r] = NEGBIG; } }
            } else {
                if (t == tmax_w) { const int il = qrow - 64 * t;
#pragma unroll
                    for (int r = 0; r < 16; ++r) { const int j0 = crow(r, hi), j1 = j0 + 32;
                        s0[r] = s0[r] * C2 + slope_l2 * (float)(j0 > il ? 2 * il - j0 : j0); s1[r] = s1[r] * C2 + slope_l2 * (float)(j1 > il ? 2 * il - j1 : j1); }
                } else {
#pragma unroll
                    for (int r = 0; r < 16; ++r) { const float cc = slope_l2 * (float)crow(r, 0); s0[r] = s0[r] * C2 + cc; s1[r] = s1[r] * C2 + cc; }
                    c32 = 32.f * slope_l2; hadd = hterm;
                }
            }
            float mx0 = s0[0], mx1 = s1[0];
#pragma unroll
            for (int r = 1; r < 16; ++r) { mx0 = fmaxf(mx0, s0[r]); mx1 = fmaxf(mx1, s1[r]); }
            float mx = fmaxf(mx0, mx1 + c32) + hadd;
            mx = half_max(mx) + base_t;
            const float mnew = fmaxf(mrun, mx), msub = mnew - base_t - hadd, msub1 = msub - c32;
            if (__any(mnew > mrun)) { const float alpha = __builtin_amdgcn_exp2f(mrun - mnew); lrun *= alpha;
#pragma unroll
                for (int db = 0; db < DV / 32; ++db)
#pragma unroll
                    for (int r = 0; r < 16; ++r) O[db][r] *= alpha; }
            mrun = mnew;
#define AT_RDH(dst, dp, kh) do { _Pragma("unroll") for (int d_ = 0; d_ < 2; ++d_) _Pragma("unroll") for (int k_ = 0; k_ < 2; ++k_) { \
                dst[d_ * 4 + k_ * 2] = vtr(vb + (16 * (2 * (kh) + k_)) * VP + (2 * (dp) + d_) * 64); dst[d_ * 4 + k_ * 2 + 1] = vtr(vb + (16 * (2 * (kh) + k_) + 8) * VP + (2 * (dp) + d_) * 64); } } while (0)
#define AT_PVH(cur, dp, kh) do { _Pragma("unroll") for (int d_ = 0; d_ < 2; ++d_) _Pragma("unroll") for (int k_ = 0; k_ < 2; ++k_) { \
                const s16x4 lo_ = cur[d_ * 4 + k_ * 2], hi_ = cur[d_ * 4 + k_ * 2 + 1]; \
                const bf16x8 vf_ = (bf16x8){lo_[0], lo_[1], lo_[2], lo_[3], hi_[0], hi_[1], hi_[2], hi_[3]}; \
                O[2 * (dp) + d_] = __builtin_amdgcn_mfma_f32_32x32x16_bf16(vf_, __builtin_bit_cast(bf16x8, pw[2 * (kh) + k_]), O[2 * (dp) + d_], 0, 0, 0); } } while (0)
            __builtin_amdgcn_sched_barrier(0);
            AT_RDH(vfa, 0, 0);
            __builtin_amdgcn_sched_barrier(0);
            float ps = 0.f; u32x4 pw[4];
#pragma unroll
            for (int r = 0; r < 16; ++r) { s0[r] = __builtin_amdgcn_exp2f(s0[r] - msub); ps += s0[r]; }
#pragma unroll
            for (int i = 0; i < 4; ++i) { pw[0][i] = pk2(s0[2 * i], s0[2 * i + 1]); pw[1][i] = pk2(s0[8 + 2 * i], s0[8 + 2 * i + 1]); }
            __builtin_amdgcn_sched_barrier(0);
            if constexpr (DV == 128) AT_RDH(vfb, 1, 0); else AT_RDH(vfb, 0, 1);
            __builtin_amdgcn_sched_barrier(0);
            __builtin_amdgcn_s_setprio(1);
            AT_PVH(vfa, 0, 0);
            if constexpr (DV == 128) AT_PVH(vfb, 1, 0);
#pragma unroll
            for (int r = 0; r < 16; ++r) { s1[r] = __builtin_amdgcn_exp2f(s1[r] - msub1); ps += s1[r]; }
#pragma unroll
            for (int i = 0; i < 4; ++i) { pw[2][i] = pk2(s1[2 * i], s1[2 * i + 1]); pw[3][i] = pk2(s1[8 + 2 * i], s1[8 + 2 * i + 1]); }
#pragma unroll
            for (int i = 0; i < (DV == 128 ? 8 : 4); ++i) { __builtin_amdgcn_sched_group_barrier(0x008, 1, 0); __builtin_amdgcn_sched_group_barrier(0x402, (DV == 128 ? 7 : 14), 0); }
            __builtin_amdgcn_sched_barrier(0);
            if constexpr (DV == 128) {
                AT_RDH(vfa, 0, 1); AT_RDH(vfb, 1, 1); __builtin_amdgcn_sched_barrier(0);
                AT_PVH(vfa, 0, 1); AT_PVH(vfb, 1, 1);
            } else {
                AT_PVH(vfb, 0, 1);
            }
            __builtin_amdgcn_s_setprio(0);
            lrun += ps;
            __builtin_amdgcn_sched_barrier(0);
#undef AT_PVH
#undef AT_RDH
#undef AT_RDV
        }
        }
        if (lane == 0) flags[(pr & 1) * 8 + w] = done ? 1 : 0;
      }
      --t; ++it; if (t < 0) break;
    }
#undef AT_ISSUE
    __syncthreads();
    l_out = half_sum(lrun);
}

DI void fox_unit(const Args& a, LAS unsigned char* lds, int l, int b, int h, int qb) {
    const int tid = lt_tid(), lane = tid & 63, w = tid >> 6, r32 = lane & 31, hi = lane >> 5;
    const bf16_t* P = (const bf16_t*)(WSP(a) + WS_UP); bf16_t* CAT = (bf16_t*)(WSP(a) + WS_H);
    const size_t rowbase = (size_t)b * SEQ; const int q0 = qb * 256;
    f32x16 O[2]; float lt;
    const float sb = C2 * sqrtf(((const float*)(WSP(a) + WS_LAM))[80 + (l * 2 + b) * 12 + h]);
    attn_pass<64, true, 0>(lds, P, rowbase, q0, PC_QA + h * 64, PC_KA + h * 64, PC_VA + h * 64, (const float*)(WSP(a) + WS_CLOC), (const float*)(WSP(a) + WS_CTOT) + b * 64 * 4, h, sb, O, lt);
    const float inv = 1.f / lt;
    bf16_t* op = CAT + (rowbase + q0 + 32 * w + r32) * DM + h * 64;
#pragma unroll
    for (int db = 0; db < 2; ++db)
#pragma unroll
        for (int g = 0; g < 4; ++g) { u32x2 wv; wv.x = pk2(O[db][4 * g] * inv, O[db][4 * g + 1] * inv); wv.y = pk2(O[db][4 * g + 2] * inv, O[db][4 * g + 3] * inv);
            *(u32x2*)(op + db * 32 + 8 * g + 4 * hi) = wv; }
}
typedef _Float16 h16x4 __attribute__((ext_vector_type(4)));
DI void diff_pass_unit(const Args& a, LAS unsigned char* lds, int l, int b, int h, int qb, int pass) {
    const bf16_t* P = (const bf16_t*)(WSP(a) + WS_UP);
    const size_t rowbase = (size_t)b * SEQ; const int q0 = qb * 256;
    const float sb = C2 * sqrtf(((const float*)(WSP(a) + WS_LAM))[80 + (l * 2 + b) * 12 + 4 + h * 2 + pass]);
    f32x16 O[4]; float lt;
    const int qc = PC_QC + h * 128 + pass * 64, kc = PC_KC + h * 128 + pass * 64, vc = PC_VC + h * 128;
    if (h == 0) attn_pass<128, false, 0>(lds, P, rowbase, q0, qc, kc, vc, nullptr, nullptr, h, sb, O, lt);
    else if (h == 1) attn_pass<128, false, 1>(lds, P, rowbase, q0, qc, kc, vc, nullptr, nullptr, h, sb, O, lt);
    else if (h == 2) attn_pass<128, false, 2>(lds, P, rowbase, q0, qc, kc, vc, nullptr, nullptr, h, sb, O, lt);
    else attn_pass<128, false, 3>(lds, P, rowbase, q0, qc, kc, vc, nullptr, nullptr, h, sb, O, lt);
    const int tid = lt_tid(), lane = tid & 63, w = tid >> 6, r32 = lane & 31, hi = lane >> 5;
    const float inv = 1.f / lt;
    _Float16* op = (_Float16*)(WSP(a) + WS_OSCR) + ((size_t)pass * NTP + rowbase + q0 + 32 * w + r32) * 512 + h * 128;
#pragma unroll
    for (int db = 0; db < 4; ++db)
#pragma unroll
        for (int g = 0; g < 4; ++g) { h16x4 v; v[0] = (_Float16)(O[db][4 * g] * inv); v[1] = (_Float16)(O[db][4 * g + 1] * inv); v[2] = (_Float16)(O[db][4 * g + 2] * inv); v[3] = (_Float16)(O[db][4 * g + 3] * inv);
            *(h16x4*)(op + db * 32 + 8 * g + 4 * hi) = v; }
}
DI void phase_diff_combine(const Args& a, int l) {
    const int tid = lt_tid(), lane = tid & 63, wave = tid >> 6;
    const float lam = ((const float*)(WSP(a) + WS_LAM))[l]; const float omli = one_minus_lam_init(l);
    const _Float16* OS = (const _Float16*)(WSP(a) + WS_OSCR); bf16_t* CAT = (bf16_t*)(WSP(a) + WS_H);
    const float* gd = AIN(a, I_GDIFF) + l * 128 + (lane & 15) * 8;
    const f32x4 g0 = *(const f32x4*)gd, g1 = *(const f32x4*)(gd + 4);
    for (int m = blockIdx.x * 8 + wave; m < NTP; m += gridDim.x * 8) {
        const h16x4* p0 = (const h16x4*)(OS + (size_t)m * 512 + lane * 8); const h16x4* p1 = (const h16x4*)(OS + ((size_t)NTP + m) * 512 + lane * 8);
        const h16x4 a0 = p0[0], a1 = p0[1], b0 = p1[0], b1 = p1[1];
        float o[8]; float ss = 0.f;
#pragma unroll
        for (int j = 0; j < 4; ++j) { o[j] = (float)a0[j] - lam * (float)b0[j]; o[4 + j] = (float)a1[j] - lam * (float)b1[j]; }
#pragma unroll
        for (int j = 0; j < 8; ++j) ss += o[j] * o[j];
#pragma unroll
        for (int x = 1; x < 16; x <<= 1) ss += __shfl_xor(ss, x);
        const float rr = rsqrtf(ss * (1.f / 128.f) + EPS) * omli;
        u32x4 wv; wv.x = pk2(o[0] * rr * g0[0], o[1] * rr * g0[1]); wv.y = pk2(o[2] * rr * g0[2], o[3] * rr * g0[3]); wv.z = pk2(o[4] * rr * g1[0], o[5] * rr * g1[1]); wv.w = pk2(o[6] * rr * g1[2], o[7] * rr * g1[3]);
        *(u32x4*)(CAT + (size_t)m * DM + 512 + lane * 8) = wv;
    }
}
DI void kn_item(const Args& a, int l, int tile, int lane) {
    const bf16_t* P = (const bf16_t*)(WSP(a) + WS_UP); unsigned* KN = (unsigned*)(WSP(a) + WS_LAM) + 80 + (l * 2 + (tile >> 8)) * 12;
    const bf16_t* rp = P + (size_t)(tile * 64 + lane) * NPROJ;
#pragma unroll 4
    for (int hm = 0; hm < 12; ++hm) { const bf16_t* kp = rp + (hm < 4 ? PC_KA + hm * 64 : PC_KC + (hm - 4) * 64); float ss = 0.f;
#pragma unroll
        for (int i = 0; i < 8; ++i) { const u32x4 r = *(const u32x4*)(kp + 8 * i);
#pragma unroll
            for (int j = 0; j < 4; ++j) { const float x = __uint_as_float(r[j] << 16), y = __uint_as_float(r[j] & 0xffff0000u); ss += x * x + y * y; } }
        ss = wave_max(ss); if (lane == 0) atomicMax(KN + hm, __float_as_uint(ss)); }
}

DI void gla_local_item(const Args& a, LAS unsigned char* lds, int l, int b, int n) {
    lds = lnd(lds);
    const int tid = lt_tid();
    const bf16_t* P = (const bf16_t*)(WSP(a) + WS_UP); const float* PF = (const float*)(WSP(a) + WS_PF);
    LAS float* gb = (LAS float*)lds;
    LAS float* cb = gb + 64 * 16;
    LAS float* kl = cb + 64 * 128;
    LAS float* vv = kl + 64 * 128;
    const size_t m0 = (size_t)b * SEQ + 64 * n;
    { const int t = tid >> 3, c = (tid & 7) * 2; const float* p = PF + (m0 + t) * 32 + 4 + c; gb[t * 16 + c] = p[0]; gb[t * 16 + c + 1] = p[1]; }
#pragma unroll
    for (int i = 0; i < 2; ++i) { const int ch = tid + 512 * i, t = ch >> 4, c = (ch & 15) * 8; const u32x4 r = *(const u32x4*)(P + (m0 + t) * NPROJ + PC_KB + c);
#pragma unroll
        for (int j = 0; j < 4; ++j) { kl[t * 128 + c + 2 * j] = __uint_as_float(r[j] << 16); kl[t * 128 + c + 2 * j + 1] = __uint_as_float(r[j] & 0xffff0000u); } }
#pragma unroll
    for (int i = 0; i < 4; ++i) { const int ch = tid + 512 * i, t = ch >> 5, c = (ch & 31) * 8; const u32x4 r = *(const u32x4*)(P + (m0 + t) * NPROJ + PC_VB + c);
#pragma unroll
        for (int j = 0; j < 4; ++j) { vv[t * 256 + c + 2 * j] = __uint_as_float(r[j] << 16); vv[t * 256 + c + 2 * j + 1] = __uint_as_float(r[j] & 0xffff0000u); } }
    __syncthreads();
    { const int col = tid & 127, tq = tid >> 7; float W[16];
#pragma unroll
      for (int r = 0; r < 16; ++r) W[r] = AIN(a, I_WGU)[(l * 16 + r) * 128 + col];
      const float bu = AIN(a, I_BGU)[l * 128 + col];
      for (int t = tq * 16; t < tq * 16 + 16; ++t) { float z = bu;
#pragma unroll
          for (int r4 = 0; r4 < 4; ++r4) { const f32x4 gq = *(const LAS f32x4*)(gb + t * 16 + 4 * r4); z += (gq.x * W[4 * r4] + gq.y * W[4 * r4 + 1]) + (gq.z * W[4 * r4 + 2] + gq.w * W[4 * r4 + 3]); }
          cb[t * 128 + col] = logsig(z) * (1.f / 16.f); } }
    __syncthreads();
    { const int col = tid & 127, q = tid >> 7; float v[16]; float run = 0.f;
#pragma unroll
      for (int i = 0; i < 16; ++i) { run += cb[(q * 16 + i) * 128 + col]; v[i] = run; }
      gb[q * 128 + col] = run;
      __syncthreads();
      float off = 0.f;
#pragma unroll
      for (int qq = 0; qq < 3; ++qq) if (qq < q) off += gb[qq * 128 + col];
#pragma unroll
      for (int i = 0; i < 16; ++i) cb[(q * 16 + i) * 128 + col] = v[i] + off; }
    __syncthreads();
    { float* CB = (float*)(WSP(a) + WS_CB) + m0 * 128;
#pragma unroll
      for (int i = 0; i < 16; ++i) { const int e = tid + 512 * i, c = e & 127; const float cv = cb[e]; CB[e] = cv; kl[e] *= __expf(cb[63 * 128 + c] - cv); }
      if (tid < 128) ((float*)(WSP(a) + WS_GDEC))[((size_t)(b * 256 + n) * 4) * 32 + tid] = __expf(cb[63 * 128 + tid]); }
    __syncthreads();
    { const int h = tid >> 7, kh = (tid >> 6) & 1, v = tid & 63; float acc[16];
#pragma unroll
      for (int k = 0; k < 16; ++k) acc[k] = 0.f;
#pragma unroll 4
      for (int t = 0; t < 64; ++t) { const float vx = vv[t * 256 + h * 64 + v]; const LAS f32x4* kr = (const LAS f32x4*)(kl + t * 128 + h * 32 + kh * 16);
#pragma unroll
          for (int k4 = 0; k4 < 4; ++k4) { const f32x4 kq = kr[k4]; acc[4 * k4] += kq.x * vx; acc[4 * k4 + 1] += kq.y * vx; acc[4 * k4 + 2] += kq.z * vx; acc[4 * k4 + 3] += kq.w * vx; } }
      float* U = (float*)(WSP(a) + WS_GU) + ((size_t)((b * 256 + n) * 4 + h) * 32 + kh * 16) * 64 + v;
#pragma unroll
      for (int k = 0; k < 16; ++k) U[k * 64] = acc[k]; }
    __syncthreads();
}
DI void gla_scan_item(const Args& a, int l, int item) {
    const int tid = lt_tid(), b = item >> 4, h = (item >> 2) & 3, e = (item & 3) * 512 + tid, k = e >> 6;
    const float* U = (const float*)(WSP(a) + WS_GU); const float* DEC = (const float*)(WSP(a) + WS_GDEC); float* GS = (float*)(WSP(a) + WS_GS);
    float S = 0.f;
#pragma unroll 32
    for (int n = 0; n < 256; ++n) { const size_t ch = (size_t)(b * 256 + n) * 4 + h; GS[ch * 2048 + e] = S; S = DEC[ch * 32 + k] * S + U[ch * 2048 + e]; }
    OUTP(a)[O_GSP + (size_t)((l * 2 + b) * 4 + h) * 2048 + e] = S;
}
DI void gla_out_item(const Args& a, LAS unsigned char* lds, int l, int b, int n, int h) {
    lds = lnd(lds);
    const int tid = lt_tid(), lane = tid & 63, wv = tid >> 6;
    const bf16_t* P = (const bf16_t*)(WSP(a) + WS_UP); bf16_t* CAT = (bf16_t*)(WSP(a) + WS_H);
    LAS float* qe = (LAS float*)lds;
    LAS float* ke = qe + 64 * 36;
    LAS float* vv = ke + 64 * 36;
    LAS float* Ss = vv + 64 * 64;
    LAS float* A = Ss + 32 * 64;
    LAS float* rb = A + 64 * 68;
    const size_t m0 = (size_t)b * SEQ + 64 * n;
    { const int half = tid >> 8, c = tid & 255, t = c >> 2, k0 = (c & 3) * 8;
      const u32x4 r = *(const u32x4*)(P + (m0 + t) * NPROJ + (half ? PC_KB : PC_QB) + h * 32 + k0);
      const float* cp = (const float*)(WSP(a) + WS_CB) + (m0 + t) * 128 + h * 32 + k0; const f32x4 c0 = *(const f32x4*)cp, c1 = *(const f32x4*)(cp + 4);
      LAS float* dst = (half ? ke : qe) + t * 36 + k0;
#pragma unroll
      for (int j = 0; j < 4; ++j) { const float x0 = __uint_as_float(r[j] << 16), x1 = __uint_as_float(r[j] & 0xffff0000u); const float ca = (j < 2 ? c0[2 * j] : c1[2 * j - 4]), cb1 = (j < 2 ? c0[2 * j + 1] : c1[2 * j - 3]);
          dst[2 * j] = half ? x0 * __expf(-ca) : x0 * 0.17677669529663687f * __expf(ca); dst[2 * j + 1] = half ? x1 * __expf(-cb1) : x1 * 0.17677669529663687f * __expf(cb1); } }
    { const int t = tid >> 3, c = (tid & 7) * 8; const u32x4 r = *(const u32x4*)(P + (m0 + t) * NPROJ + PC_VB + h * 64 + c), r2 = *(const u32x4*)(P + (m0 + t) * NPROJ + PC_RB + h * 64 + c);
#pragma unroll
      for (int j = 0; j < 4; ++j) { vv[t * 64 + c + 2 * j] = __uint_as_float(r[j] << 16); vv[t * 64 + c + 2 * j + 1] = __uint_as_float(r[j] & 0xffff0000u);
          rb[t * 64 + c + 2 * j] = silu_f(__uint_as_float(r2[j] << 16)); rb[t * 64 + c + 2 * j + 1] = silu_f(__uint_as_float(r2[j] & 0xffff0000u)); } }
    { const float* GS = (const float*)(WSP(a) + WS_GS) + ((size_t)(b * 256 + n) * 4 + h) * 2048; *(LAS f32x4*)(Ss + tid * 4) = *(const f32x4*)(GS + tid * 4); }
    __syncthreads();
    { float acc[8];
#pragma unroll
      for (int i = 0; i < 8; ++i) acc[i] = 0.f;
#pragma unroll
      for (int k4 = 0; k4 < 8; ++k4) { const f32x4 kv = *(const LAS f32x4*)(ke + lane * 36 + 4 * k4);
#pragma unroll
          for (int i = 0; i < 8; ++i) { const f32x4 qv = *(const LAS f32x4*)(qe + (wv + 8 * i) * 36 + 4 * k4); acc[i] += (qv.x * kv.x + qv.y * kv.y) + (qv.z * kv.z + qv.w * kv.w); } }
#pragma unroll
      for (int i = 0; i < 8; ++i) A[(wv + 8 * i) * 68 + lane] = (lane <= wv + 8 * i) ? acc[i] : 0.f; }
    __syncthreads();
    float o[8];
#pragma unroll
    for (int i = 0; i < 8; ++i) o[i] = 0.f;
#pragma unroll 4
    for (int m4 = 0; m4 < 16; ++m4) { const float v0 = vv[(4 * m4) * 64 + lane], v1 = vv[(4 * m4 + 1) * 64 + lane], v2 = vv[(4 * m4 + 2) * 64 + lane], v3 = vv[(4 * m4 + 3) * 64 + lane];
#pragma unroll
        for (int i = 0; i < 8; ++i) { const f32x4 av = *(const LAS f32x4*)(A + (wv + 8 * i) * 68 + 4 * m4); o[i] += (av.x * v0 + av.y * v1) + (av.z * v2 + av.w * v3); } }
#pragma unroll 4
    for (int k4 = 0; k4 < 8; ++k4) { const float s0 = Ss[(4 * k4) * 64 + lane], s1 = Ss[(4 * k4 + 1) * 64 + lane], s2 = Ss[(4 * k4 + 2) * 64 + lane], s3 = Ss[(4 * k4 + 3) * 64 + lane];
#pragma unroll
        for (int i = 0; i < 8; ++i) { const f32x4 qv = *(const LAS f32x4*)(qe + (wv + 8 * i) * 36 + 4 * k4); o[i] += (qv.x * s0 + qv.y * s1) + (qv.z * s2 + qv.w * s3); } }
    const float gg = AIN(a, I_GGLA)[l * 64 + lane];
#pragma unroll
    for (int i = 0; i < 8; ++i) { const int t = wv + 8 * i; const float rr = rsqrtf(wave_sum(o[i] * o[i]) * (1.f / 64.f) + EPS);
        CAT[(m0 + t) * DM + 256 + h * 64 + lane] = (bf16_t)(pk2(o[i] * rr * gg * rb[t * 64 + lane], 0.f) & 0xffffu); }
    __syncthreads();
}

DI void logf_item(const Args& a, int l, int tile, int h, int lane) {
    const float* PF = (const float*)(WSP(a) + WS_PF); const float bf = AIN(a, I_BF)[l * 4 + h];
    const int m0 = tile * 256 + 4 * lane; float lf[4];
#pragma unroll
    for (int i = 0; i < 4; ++i) lf[i] = logsig(PF[(size_t)(m0 + i) * 32 + h] + bf);
    if (tile == 128) {
#pragma unroll
        for (int i = 0; i < 4; ++i) OUTP(a)[O_FLS + ((size_t)l * NTS + (m0 + i - NTP)) * 4 + h] = lf[i];
        return; }
#pragma unroll
    for (int i = 0; i < 4; ++i) OUTP(a)[O_FLP + ((size_t)l * NTP + m0 + i) * 4 + h] = lf[i];
    lf[1] += lf[0]; lf[2] += lf[1]; lf[3] += lf[2];
    float inc = lf[3];
#pragma unroll
    for (int o = 1; o < 64; o <<= 1) { const float v = __shfl_up(inc, o); if (lane >= o) inc += v; }
    const float excl = inc - lf[3];
    float* CL = (float*)(WSP(a) + WS_CLOC);
#pragma unroll
    for (int i = 0; i < 4; ++i) CL[(size_t)(m0 + i) * 4 + h] = excl + lf[i];
    if (lane == 63) ((float*)(WSP(a) + WS_CTOT))[tile * 4 + h] = inc;
}

#define MINI_IN_GEMM 1
constexpr int NKS = 1040;
DI void samp_softmax(LAS float* S, LAS float* linv, int tid) {
    const int lane = tid & 63, wv = tid >> 6;
#pragma unroll
    for (int rr = 0; rr < 2; ++rr) { LAS float* row = S + (2 * wv + rr) * NKS; float mx = NEGBIG;
        for (int j = lane; j < NKS; j += 64) mx = fmaxf(mx, row[j]);
        mx = wave_max(mx); float sm = 0.f;
        for (int j = lane; j < NKS; j += 64) { const float p = __expf(row[j] - mx); row[j] = p; sm += p; }
        sm = wave_sum(sm); if (lane == 0) linv[2 * wv + rr] = 1.f / sm; }
}
template <bool FOX>
DI void samp_scores(LAS float* S, const LAS float* qs, const LAS float* caux, const float* kc, const float* kn, int KW, float slope, int tid) {
    const float cref = FOX ? caux[NKS - 1] : 0.f;
    for (int j = tid; j < NKS; j += 512) {
        const float* kr = j < 1024 ? kc + (size_t)j * KW : kn + (size_t)(j - 1024) * KW;
        f32x4 kv[16];
#pragma unroll
        for (int i = 0; i < 16; ++i) kv[i] = *(const f32x4*)(kr + 4 * i);
        const float bj = FOX ? cref - caux[j] : 0.f;
#pragma unroll 4
        for (int qi = 0; qi < 16; ++qi) { float d = 0.f;
#pragma unroll
            for (int i = 0; i < 16; ++i) { const f32x4 q = *(const LAS f32x4*)(qs + qi * 64 + 4 * i); d += (q.x * kv[i].x + q.y * kv[i].y) + (q.z * kv[i].z + q.w * kv[i].w); }
            float s = d * 0.125f;
            if (FOX) { s += bj; if (j > 1024 + qi) s = NEGBIG; } else s -= slope * fabsf((float)(1024 + qi - j));
            S[qi * NKS + j] = s; }
    }
}
DI void fox_sample_item(const Args& a, LAS unsigned char* lds, int l, int b, int h) {
    lds = lnd(lds);
    const int tid = lt_tid(), lane = tid & 63;
    const bf16_t* P = (const bf16_t*)(WSP(a) + WS_UP); bf16_t* CAT = (bf16_t*)(WSP(a) + WS_H);
    LAS float* S = (LAS float*)lds; LAS float* qs = S + 16 * NKS; LAS float* caux = qs + 16 * 64; LAS float* linv = caux + NKS + 8;
    const int m0 = NTP + b * 16; const size_t lb = (size_t)l * 16 + b;
    for (int e = tid; e < 1024; e += 512) qs[e] = bf2f(P[(size_t)(m0 + (e >> 6)) * NPROJ + PC_QA + h * 64 + (e & 63)]);
    if (tid < 64) { const float* cl = AIN(a, I_CFL) + (lb * 1024 + 16 * lane) * 4 + h; float v[16]; float run = 0.f;
#pragma unroll
        for (int i = 0; i < 16; ++i) { run += cl[i * 4]; v[i] = run; }
        float inc = run;
#pragma unroll
        for (int o = 1; o < 64; o <<= 1) { const float t = __shfl_up(inc, o); if (lane >= o) inc += t; }
        const float ex = inc - run;
#pragma unroll
        for (int i = 0; i < 16; ++i) caux[16 * lane + i] = ex + v[i]; }
    __syncthreads();
    if (tid == 0) { float run = caux[1023]; for (int t = 0; t < 16; ++t) { run += OUTP(a)[O_FLS + (lb * 16 + t) * 4 + h]; caux[1024 + t] = run; } }
    __syncthreads();
    samp_scores<true>(S, qs, caux, AIN(a, I_CFK) + (lb * 1024 * 4 + h) * 64, OUTP(a) + O_FKS + (lb * 16 * 4 + h) * 64, 256, 0.f, tid);
    __syncthreads();
    samp_softmax(S, linv, tid);
    __syncthreads();
    {
      const int wv = tid >> 6; LAS float* red = (LAS float*)(lds + 80000);
      const float* vc = AIN(a, I_CFV) + (lb * 1024 * 4 + h) * 64 + lane; const float* vn = OUTP(a) + O_FVS + (lb * 16 * 4 + h) * 64 + lane;
      float acc[16];
#pragma unroll
      for (int i = 0; i < 16; ++i) acc[i] = 0.f;
#pragma unroll 5
      for (int jj = 0; jj < 130; ++jj) { const int j = 130 * wv + jj; const float v = j < 1024 ? vc[(size_t)j * 256] : vn[(size_t)(j - 1024) * 256];
#pragma unroll
          for (int i = 0; i < 16; ++i) acc[i] += S[i * NKS + j] * v; }
#pragma unroll
      for (int i = 0; i < 16; ++i) red[(wv * 16 + i) * 64 + lane] = acc[i];
      __syncthreads();
      const int d = tid & 63, qg = tid >> 6;
#pragma unroll
      for (int r = 0; r < 2; ++r) { const int qi = 2 * qg + r; float sum = 0.f;
#pragma unroll
          for (int x = 0; x < 8; ++x) sum += red[(x * 16 + qi) * 64 + d];
          CAT[(size_t)(m0 + qi) * DM + h * 64 + d] = (bf16_t)(pk2(sum * linv[qi], 0.f) & 0xffffu); } }
    __syncthreads();
}
DI void diff_sample_item(const Args& a, LAS unsigned char* lds, int l, int b, int h) {
    lds = lnd(lds);
    const int tid = lt_tid(), lane = tid & 63, wv = tid >> 6;
    const bf16_t* P = (const bf16_t*)(WSP(a) + WS_UP); bf16_t* CAT = (bf16_t*)(WSP(a) + WS_H);
    LAS float* S = (LAS float*)lds; LAS float* qs = S + 16 * NKS; LAS float* caux = qs + 16 * 64; LAS float* linv = caux + NKS + 8; LAS float* red = linv + 16;
    const int m0 = NTP + b * 16; const size_t lb = (size_t)l * 16 + b;
    const float slope = exp2f(-2.f * (float)(h + 1)), lam = ((const float*)(WSP(a) + WS_LAM))[l]; const float omli = one_minus_lam_init(l);
    const int d = tid & 127, qg = tid >> 7;
    float o[4] = {0.f, 0.f, 0.f, 0.f};
    for (int mp = 0; mp < 2; ++mp) {
        for (int e = tid; e < 1024; e += 512) qs[e] = bf2f(P[(size_t)(m0 + (e >> 6)) * NPROJ + PC_QC + h * 128 + mp * 64 + (e & 63)]);
        __syncthreads();
        samp_scores<false>(S, qs, caux, AIN(a, I_CDK) + (lb * 1024 * 4 + h) * 128 + mp * 64, OUTP(a) + O_DKS + (lb * 16 * 4 + h) * 128 + mp * 64, 512, slope, tid);
        __syncthreads();
        samp_softmax(S, linv, tid);
        __syncthreads();
        { LAS float* redv = (LAS float*)(lds + 80000);
          const float* vc = AIN(a, I_CDV) + (lb * 1024 * 4 + h) * 128 + lane; const float* vn = OUTP(a) + O_DVS + (lb * 16 * 4 + h) * 128 + lane;
          float acc0[16], acc1[16];
#pragma unroll
          for (int i = 0; i < 16; ++i) { acc0[i] = 0.f; acc1[i] = 0.f; }
#pragma unroll 5
          for (int jj = 0; jj < 130; ++jj) { const int j = 130 * wv + jj; const float* vp = j < 1024 ? vc + (size_t)j * 512 : vn + (size_t)(j - 1024) * 512; const float v0 = vp[0], v1 = vp[64];
#pragma unroll
              for (int i = 0; i < 16; ++i) { const float p = S[i * NKS + j]; acc0[i] += p * v0; acc1[i] += p * v1; } }
#pragma unroll
          for (int i = 0; i < 16; ++i) { redv[(wv * 16 + i) * 128 + lane] = acc0[i]; redv[(wv * 16 + i) * 128 + 64 + lane] = acc1[i]; }
          __syncthreads();
#pragma unroll
          for (int i = 0; i < 4; ++i) { float sum = 0.f;
#pragma unroll
              for (int x = 0; x < 8; ++x) sum += redv[(x * 16 + 4 * qg + i) * 128 + d];
              const float v = sum * linv[4 * qg + i]; o[i] = (mp == 0) ? v : o[i] - lam * v; } }
        __syncthreads();
    }
#pragma unroll
    for (int i = 0; i < 4; ++i) { const float s = wave_sum(o[i] * o[i]); if (lane == 0) red[wv * 4 + i] = s; }
    __syncthreads();
    const float gd = AIN(a, I_GDIFF)[l * 128 + d] * omli;
#pragma unroll
    for (int i = 0; i < 4; ++i) { const float tot = red[(2 * qg) * 4 + i] + red[(2 * qg + 1) * 4 + i]; const float rr = rsqrtf(tot * (1.f / 128.f) + EPS);
        CAT[(size_t)(m0 + 4 * qg + i) * DM + 512 + h * 128 + d] = (bf16_t)(pk2(o[i] * rr * gd, 0.f) & 0xffffu); }
    __syncthreads();
}
DI void gla_sample_item(const Args& a, int l, int b, int h, int lane) {
    const bf16_t* P = (const bf16_t*)(WSP(a) + WS_UP); bf16_t* CAT = (bf16_t*)(WSP(a) + WS_H); const float* PF = (const float*)(WSP(a) + WS_PF);
    const size_t sb = (((size_t)l * 16 + b) * 4 + h) * 2048;
    float S[32];
#pragma unroll
    for (int k = 0; k < 32; ++k) S[k] = AIN(a, I_SG)[sb + k * 64 + lane];
    const int kk = lane & 31; float W[16];
#pragma unroll
    for (int r = 0; r < 16; ++r) W[r] = AIN(a, I_WGU)[(l * 16 + r) * 128 + h * 32 + kk];
    const float bu = AIN(a, I_BGU)[l * 128 + h * 32 + kk], gg = AIN(a, I_GGLA)[l * 64 + lane];
    for (int t = 0; t < 16; ++t) { const size_t m = NTP + b * 16 + t;
        float z = bu;
#pragma unroll
        for (int r = 0; r < 16; ++r) z += PF[m * 32 + 4 + r] * W[r];
        const float av = __expf(logsig(z) * (1.f / 16.f));
        const float qv = bf2f(P[m * NPROJ + PC_QB + h * 32 + kk]) * 0.17677669529663687f, kv = bf2f(P[m * NPROJ + PC_KB + h * 32 + kk]);
        const float vx = bf2f(P[m * NPROJ + PC_VB + h * 64 + lane]);
        float o = 0.f;
#pragma unroll
        for (int k = 0; k < 32; ++k) { const float ak = __shfl(av, k), kx = __shfl(kv, k), qx = __shfl(qv, k); S[k] = ak * S[k] + kx * vx; o += qx * S[k]; }
        const float rr = rsqrtf(wave_sum(o * o) * (1.f / 64.f) + EPS);
        const float rb = bf2f(P[m * NPROJ + PC_RB + h * 64 + lane]);
        CAT[m * DM + 256 + h * 64 + lane] = (bf16_t)(pk2(o * rr * gg * silu_f(rb), 0.f) & 0xffffu); }
#pragma unroll
    for (int k = 0; k < 32; ++k) OUTP(a)[O_GSS + sb + k * 64 + lane] = S[k];
}


DI void mini_tile(const bf16_t* __restrict__ A, int lda, const bf16_t* __restrict__ Bt, int ldb, int row0, int brow0, int k0, int ksteps, f32x16& acc, int r32, int hi) {
    const bf16_t* ap = A + (size_t)(row0 + r32) * lda + k0 + 8 * hi; const bf16_t* bp = Bt + (size_t)(brow0 + r32) * ldb + k0 + 8 * hi;
#pragma unroll 8
    for (int s = 0; s < ksteps; ++s) { const bf16x8 av = *(const bf16x8*)(ap + 16 * s), bv = *(const bf16x8*)(bp + 16 * s); acc = __builtin_amdgcn_mfma_f32_32x32x16_bf16(bv, av, acc, 0, 0, 0); }
}
DI void mini_swiglu(const Args& a, int l, int i) {
    const int tid = lt_tid(), lane = tid & 63, wave = tid >> 6, r32 = lane & 31, hi = lane >> 5;
    const bf16_t* H = (const bf16_t*)(WSP(a) + WS_H); const bf16_t* W = (const bf16_t*)(WSP(a) + WS_WFI + (size_t)(l * 2 + i) * SZ_WFI1); bf16_t* U = (bf16_t*)(WSP(a) + WS_UP);
    for (int it = blockIdx.x * 8 + wave; it < 8 * 88; it += gridDim.x * 8) { const int mt = it / 88, g = it % 88, brow = 256 * (g >> 2) + 32 * (g & 3);
        f32x16 ag, au;
#pragma unroll
        for (int r = 0; r < 16; ++r) { ag[r] = 0.f; au[r] = 0.f; }
        const bf16_t* ap = H + (size_t)(NTP + 32 * mt + r32) * DM + 8 * hi; const bf16_t* bg = W + (size_t)(brow + r32) * DM + 8 * hi; const bf16_t* bu = bg + (size_t)128 * DM;
#pragma unroll 4
        for (int s = 0; s < 64; ++s) { const bf16x8 av = *(const bf16x8*)(ap + 16 * s), g8 = *(const bf16x8*)(bg + 16 * s), u8 = *(const bf16x8*)(bu + 16 * s);
            ag = __builtin_amdgcn_mfma_f32_32x32x16_bf16(g8, av, ag, 0, 0, 0); au = __builtin_amdgcn_mfma_f32_32x32x16_bf16(u8, av, au, 0, 0, 0); }
        bf16_t* up = U + (size_t)(NTP + 32 * mt + r32) * DFF + 32 * g + 4 * hi;
#pragma unroll
        for (int q = 0; q < 4; ++q) { u32x2 w; w.x = pk2(silu_f(ag[4 * q]) * au[4 * q], silu_f(ag[4 * q + 1]) * au[4 * q + 1]); w.y = pk2(silu_f(ag[4 * q + 2]) * au[4 * q + 2], silu_f(ag[4 * q + 3]) * au[4 * q + 3]); *(u32x2*)(up + 8 * q) = w; }
    }
}
DI void mini_f32(const Args& a, const bf16_t* A, int lda, const bf16_t* Bt, int K) {
    const int tid = lt_tid(), lane = tid & 63, wave = tid >> 6, r32 = lane & 31, hi = lane >> 5;
    float* YS = (float*)(WSP(a) + WS_YS); const int kc = K / 8;
    for (int it = blockIdx.x * 8 + wave; it < 2048; it += gridDim.x * 8) { const int ks = it & 7, nt = (it >> 3) & 31, mt = it >> 8;
        f32x16 acc;
#pragma unroll
        for (int r = 0; r < 16; ++r) acc[r] = 0.f;
        mini_tile(A, lda, Bt, K, NTP + 32 * mt, 32 * nt, ks * kc, kc / 16, acc, r32, hi);
        float* yp = YS + ((size_t)ks * NTS + 32 * mt + r32) * DM + 32 * nt + 4 * hi;
#pragma unroll
        for (int q = 0; q < 4; ++q) *(f32x4*)(yp + 8 * q) = (f32x4){acc[4 * q], acc[4 * q + 1], acc[4 * q + 2], acc[4 * q + 3]};
    }
}
DI void mini_proj(const Args& a, int l) {
    const int tid = lt_tid(), lane = tid & 63, wave = tid >> 6, r32 = lane & 31, hi = lane >> 5;
    const bf16_t* H = (const bf16_t*)(WSP(a) + WS_H); const bf16_t* W = (const bf16_t*)(WSP(a) + WS_WIN + (size_t)l * SZ_WIN1); bf16_t* P = (bf16_t*)(WSP(a) + WS_UP); float* PF = (float*)(WSP(a) + WS_PF);
    for (int it = blockIdx.x * 8 + wave; it < 8 * 97; it += gridDim.x * 8) { const int mt = it / 97, g = it % 97;
        f32x16 acc;
#pragma unroll
        for (int r = 0; r < 16; ++r) acc[r] = 0.f;
        mini_tile(H, DM, W, DM, NTP + 32 * mt, 32 * g, 0, 64, acc, r32, hi);
        const int rs = 32 * mt + r32, c0 = 32 * g + 4 * hi;
        bf16_t* pp = P + (size_t)(NTP + rs) * NPROJ + c0;
        float* dst = nullptr;
        if (g >= 8 && g < 16) dst = OUTP(a) + O_FKS + ((size_t)l * NTS + rs) * 256 + (c0 - 256);
        else if (g >= 16 && g < 24) dst = OUTP(a) + O_FVS + ((size_t)l * NTS + rs) * 256 + (c0 - 512);
        else if (g >= 64 && g < 80) dst = OUTP(a) + O_DKS + ((size_t)l * NTS + rs) * 512 + (c0 - 2048);
        else if (g >= 80 && g < 96) dst = OUTP(a) + O_DVS + ((size_t)l * NTS + rs) * 512 + (c0 - 2560);
        else if (g == 96) dst = PF + (size_t)(NTP + rs) * 32 + 4 * hi;
#pragma unroll
        for (int q = 0; q < 4; ++q) { u32x2 w; w.x = pk2(acc[4 * q], acc[4 * q + 1]); w.y = pk2(acc[4 * q + 2], acc[4 * q + 3]); *(u32x2*)(pp + 8 * q) = w;
            if (dst) *(f32x4*)(dst + 8 * q) = (f32x4){acc[4 * q], acc[4 * q + 1], acc[4 * q + 2], acc[4 * q + 3]}; }
    }
}

constexpr int N_PHASES = 32;
#ifndef PHM
#define PHM 0xffff
#endif
#define EN(b) ((PHM >> (b)) & 1)
__global__ void __launch_bounds__(512, 2) hybrid_fwd(Args a) {
    LAS unsigned char* lds_base = (LAS unsigned char*)lds_raw;
    { const unsigned hw = (unsigned)__builtin_amdgcn_s_getreg((5 << 11) | 4) & 63u;
      if ((threadIdx.x & 63) == 0) lds_base[LDS_WTAB + hw] = (unsigned char)(threadIdx.x >> 6);
      if (threadIdx.x < 2) ((LAS unsigned*)(lds_base + LDS_XBST))[threadIdx.x] = 0u;
      __syncthreads(); }
    (void)xcd_barrier_post((unsigned*)(WSP(a) + WS_BAR), (volatile LAS unsigned*)(lds_base + LDS_XBST));
    for (int pi = 0; pi < a.nph; ++pi) {
      { int pj = pi; asm volatile("" : "+s"(pj)); const int ph = a.plist[pj];
        unsigned char* ws = WSP(a);
        LAS unsigned char* lds = lnd(lds_base);
        if (ph == 0) { if (EN(0)) phase_prologue(a, lds); }
        else if (ph == 1) { if (EN(1)) phase_rows(a, 0, -1, 0.f, 0, 0, true); }
        else if (ph >= 100) { }
        else {
            const int l = (ph - 2) / 15, kp = (ph - 2) % 15;
            const int k = kp == 0 ? 0 : kp == 2 ? 1 : kp == 3 ? 2 : kp == 4 ? 3 : kp == 5 ? 4 : kp == 6 ? 5 : kp == 7 ? 6 : kp == 9 ? 7 : kp == 10 ? 8 : kp == 11 ? 9 : kp == 13 ? 10 : kp == 14 ? 11 : -1;
            if (kp == 1 || kp == 12) mini_f32(a, (const bf16_t*)(ws + WS_UP), DFF, (const bf16_t*)(ws + WS_WFO + (size_t)(l * 2 + (kp == 12)) * SZ_WFO1), DFF);
            else if (kp == 8) { phase_diff_combine(a, l); mini_f32(a, (const bf16_t*)(ws + WS_H), DM, (const bf16_t*)(ws + WS_WOUT + (size_t)l * SZ_WOUT1), DM); }
            else if (k == 0 || k == 9) { if (EN(2)) {
                const int i = (k == 9);
                pg8::Gemm g{(const bf16_t*)(ws + WS_H), (const bf16_t*)(ws + WS_WFI + (size_t)(l * 2 + i) * SZ_WFI1), MTOT, 2 * DFF, DM};
                pg8::StaticOrder S; S.init(MTOT, 2 * DFF, gridDim.x, blockIdx.x);
                EpiSwiglu E{(bf16_t*)(ws + WS_UP)};
                pg8::gemm_phase<EpiSwiglu, pg8::StaticOrder, true, true>(lds, g, S, E); }
            } else if (k == 1 || k == 10 || k == 7) { if (EN(3)) {
                const int i = (k == 10);
                pg8::Gemm g{k == 7 ? (const bf16_t*)(ws + WS_H) : (const bf16_t*)(ws + WS_UP),
                            k == 7 ? (const bf16_t*)(ws + WS_WOUT + (size_t)l * SZ_WOUT1) : (const bf16_t*)(ws + WS_WFO + (size_t)(l * 2 + i) * SZ_WFO1), NTP, DM, k == 7 ? DM : DFF};
                pg8::StaticOrder S; S.init(NTP, DM, gridDim.x, blockIdx.x);
                EpiF32 E{(bf16_t*)(ws + WS_Y)};
                pg8::gemm_phase<EpiF32, pg8::StaticOrder, true, true>(lds, g, S, E);
#ifdef MINI_IN_GEMM
                if (k != 7) mini_f32(a, (const bf16_t*)(WSP(a) + WS_UP), DFF, (const bf16_t*)(WSP(a) + WS_WFO + (size_t)(l * 2 + i) * SZ_WFO1), DFF);
#endif
                }
            } else if (k == 3) { if (EN(4)) {
                pg8::Gemm g{(const bf16_t*)(ws + WS_H), (const bf16_t*)(ws + WS_WIN + (size_t)l * SZ_WIN1), MTOT, NPROJ, DM};
                pg8::StaticOrder S; S.init(MTOT, NPROJ, gridDim.x, blockIdx.x);
                EpiProj E{(bf16_t*)(ws + WS_UP), OUTP(a), (float*)(ws + WS_PF), l};
                pg8::gemm_phase<EpiProj, pg8::StaticOrder, true, true>(lds, g, S, E); }
            } else if (k == 2) { if (EN(1)) phase_rows(a, l, 0, 0.5f, 1, l, l == 0); }
            else if (k == 8) { if (EN(1)) phase_rows(a, l, 1, 1.0f, 2, l, false); }
            else if (k == 11) { if (EN(1)) phase_rows(a, l, 2, 0.5f, l == 0 ? 0 : -1, 1, false); }
            else if (k == 4) { if (EN(5)) { const int tid = lt_tid(), lane = tid & 63, wave = tid >> 6;
                for (int it = blockIdx.x * 8 + wave; it < 129 * 4; it += gridDim.x * 8) logf_item(a, l, it >> 2, it & 3, lane);
                for (int it = blockIdx.x * 8 + wave; it < 512; it += gridDim.x * 8) kn_item(a, l, it, lane);
                for (int it = blockIdx.x; it < 512; it += gridDim.x) gla_local_item(a, lds, l, it >> 8, it & 255); }
            } else if (k == 5) { const int tid = lt_tid(), lane = tid & 63, wave = tid >> 6;
                for (int it = blockIdx.x; it < 40; it += gridDim.x) {
                    if (it < 32) gla_scan_item(a, l, it);
                    else { const int wi = (it - 32) * 8 + wave; gla_sample_item(a, l, wi >> 2, wi & 3, lane); }
                }
            } else if (k == 6) {
                const int tid = lt_tid();
                LAS int* qslot = (LAS int*)(lds + LDS_BYTES - 16); unsigned* ctr = (unsigned*)(ws + WS_LAM) + 16 + pi;
                for (;;) {
                    __syncthreads();
                    if (tid == 0) qslot[0] = (int)atomicAdd(ctr, 1u);
                    __syncthreads();
                    const int it = qslot[0];
                    if (it >= 2176) break;
                    if (it >= 256 && it < 320) fox_sample_item(a, lds, l, (it - 256) >> 2, (it - 256) & 3);
                    else if (it >= 320 && it < 384) diff_sample_item(a, lds, l, (it - 320) >> 2, (it - 320) & 3);
                    else if (it < 1152) { const int j = it < 256 ? it : it - 128, rem = j & 255; diff_pass_unit(a, lds, l, (rem >> 1) & 1, 3 - (j >> 8), 63 - (rem >> 2), rem & 1);
#ifdef PROBE_DIFF2
                        diff_pass_unit(a, lds, l, (rem >> 1) & 1, 3 - (j >> 8), 63 - (rem >> 2), rem & 1);
#endif
                    }
                    else if (it < 1664) { const int j = it - 1152; fox_unit(a, lds, l, j >> 8, (j >> 6) & 3, 63 - (j & 63)); }
                    else { const int j = (it - 1664) * 4;
                        for (int hh = 0; hh < 4; ++hh) gla_out_item(a, lds, l, j >> 10, (j >> 2) & 255, hh);
                    }
                }
            }
        }
      }
      if (pi + 1 < a.nph) {
          if (a.nph > 4096) cg::this_grid().sync();
          else { XcdBarrier bar; bar.bar = (unsigned*)(WSP(a) + WS_BAR); bar.x = xb_xcc_id(); bar.st = (volatile LAS unsigned*)(lds_base + LDS_XBST); xcd_barrier(bar); }
      }
    }
}

#ifndef MK_LAUNCHES
#define MK_LAUNCHES 1
#endif
extern "C" void kernel_launch(void* const* d_in, const int* in_sizes, int n_in, void* d_out, int out_size, void* d_ws, size_t ws_size, hipStream_t stream) {
    static int grid = 0;
    if (grid == 0) {
        if (n_in != 23 || (size_t)out_size != O_END || ws_size < WS_END) { fprintf(stderr, "kernel_launch: unexpected shapes (n_in %d out %d ws %zu need %zu)\n", n_in, out_size, ws_size, (size_t)WS_END); grid = -1; return; }
        int dev = 0, cus = 0, per_cu = 0;
        hipGetDevice(&dev); hipDeviceGetAttribute(&cus, hipDeviceAttributeMultiprocessorCount, dev);
        if (hipFuncSetAttribute((const void*)hybrid_fwd, hipFuncAttributeMaxDynamicSharedMemorySize, LDS_BYTES) != hipSuccess) { fprintf(stderr, "kernel_launch: hipFuncSetAttribute failed\n"); grid = -1; return; }
        if (hipOccupancyMaxActiveBlocksPerMultiprocessor(&per_cu, (const void*)hybrid_fwd, 512, LDS_BYTES) != hipSuccess || per_cu < 1) { fprintf(stderr, "kernel_launch: occupancy query gave %d\n", per_cu); per_cu = 1; }
        (void)hipGetLastError();
        grid = cus * per_cu; if (grid > 256) grid = 256;
        fprintf(stderr, "kernel_launch: grid %d (cus %d per_cu %d)\n", grid, cus, per_cu);
    }
    if (grid < 0) return;
    Args a{};
    for (int i = 0; i < 23; ++i) a.in[i] = (const float*)d_in[i];
    a.out = (float*)d_out; a.ws = (unsigned char*)d_ws;
    int n = 0;
#ifdef PROBE_DUP
    for (int ph = 0; ph < N_PHASES; ++ph) { a.plist[n++] = (unsigned char)ph;
#ifdef PROBE_PH01
        if (ph < 2) a.plist[n++] = (unsigned char)ph;
#endif
        if (ph >= 2) { const int kk = (ph - 2) % 15; const int grp = (kk == 0 || kk == 2 || kk == 4 || kk == 9 || kk == 11 || kk == 13) ? 1 : (kk >= 5 && kk <= 7) ? 2 : 4;
            if (PROBE_DUP & grp) a.plist[n++] = (unsigned char)ph;
#ifdef PROBE_KK
            if ((PROBE_KK >> kk) & 1) a.plist[n++] = (unsigned char)ph;
#endif
        } }
#else
    for (int ph = 0; ph < N_PHASES; ++ph) {
#ifdef MINI_IN_GEMM
        if (ph >= 2 && ((ph - 2) % 15 == 1 || (ph - 2) % 15 == 12)) continue;
#endif
        a.plist[n++] = (unsigned char)ph; }
#endif
#ifdef PROBE_SYNC
    for (int i = 0; i < PROBE_SYNC; ++i) a.plist[n++] = (unsigned char)200;
#endif
    a.nph = n;
    if (hipMemsetAsync((char*)d_ws + WS_BAR, 0, 16384, stream) != hipSuccess) { fprintf(stderr, "kernel_launch: memset of barrier words failed\n"); return; }
    void* args[] = {&a};
    hipError_t e = hipLaunchCooperativeKernel((const void*)hybrid_fwd, dim3(grid), dim3(512), args, LDS_BYTES, stream);
    if (e != hipSuccess) fprintf(stderr, "cooperative launch failed: %s (grid %d)\n", hipGetErrorString(e), grid);
}
```

```cpp
#include <hip/hip_runtime.h>
#include <hip/hip_cooperative_groups.h>
#include <hip/hip_bf16.h>
#include <cstdio>
#include <cstdint>
namespace cg = cooperative_groups;
extern __shared__ __attribute__((aligned(16))) unsigned char lds_raw[];
constexpr int LDS_WTAB = 147456 - 96;
__device__ __forceinline__ int lt_tid() {
    const unsigned hw = (unsigned)__builtin_amdgcn_s_getreg((5 << 11) | 4) & 63u;
    int w = ((const __attribute__((address_space(3))) unsigned char*)lds_raw)[LDS_WTAB + hw];
    unsigned z = 0u; asm volatile("" : "+v"(z));
    int t = (w << 6) | (int)__builtin_amdgcn_mbcnt_hi(~0u, __builtin_amdgcn_mbcnt_lo(~0u, z));
    asm volatile("" : "+v"(t)); return t;
}
namespace pg8 {
#define PG8_LAS __attribute__((address_space(3)))
typedef unsigned short bf16_t;
typedef short bf16x8 __attribute__((ext_vector_type(8)));
typedef float f32x4 __attribute__((ext_vector_type(4)));
typedef unsigned u32x4 __attribute__((ext_vector_type(4)));
constexpr int BM = 256, BK = 64, HALF = 128, HTB = HALF * BK * 2  , STAGE_BYTES = 8 * HTB, NXCD = 8, WGM = 8;

__host__ __device__ __forceinline__ int lds_byte(int r, int c) { const int st = (r >> 4) * 2 + (c >> 5), rr = r & 15, cc = c & 31, ob = rr * 64 + cc * 2; return st * 1024 + (ob ^ (((ob >> 9) & 1) << 5)); }
__host__ __device__ __forceinline__ void stage_rc(int b, int& R, int& C) { const int st = b / 1024, sb = b % 1024, swz = sb ^ (((sb >> 9) & 1) << 5); R = (st >> 1) * 16 + swz / 64; C = (st & 1) * 32 + (swz % 64) / 2; }
__host__ __device__ __forceinline__ int perm32(int rho) { const int n = rho >> 4, i = rho & 15; return 8 * (i >> 2) + 4 * n + (i & 3); }

struct Unit { int pm, pn; };
struct Gemm { const bf16_t* A; const bf16_t* Bt; int M, N, K; };

struct StaticOrder {
    int nM, nN, nwg, G, c;
    __host__ __device__ void init(int M, int N, int G_, int c_) { nM = M / BM; nN = N / BM; nwg = nM * nN; G = G_; c = c_; }
    __host__ __device__ bool next(int i, Unit& u) const {
        const long L = (long)i * G + c; if (L >= nwg) return false;
        int wgid = (int)L; { const int q = nwg / NXCD, r = nwg % NXCD, xcd = wgid % NXCD, off = wgid / NXCD; wgid = (xcd < r ? xcd * (q + 1) : r * (q + 1) + (xcd - r) * q) + off; }
        const int nig = WGM * nN, gid = wgid / nig, fm = gid * WGM, gsz = (nM - fm) < WGM ? (nM - fm) : WGM;
        u.pm = fm + ((wgid % nig) % gsz); u.pn = (wgid % nig) / gsz; return true;
    }
    __device__ __forceinline__ void a_ready(const Unit&) const {}
    __device__ __forceinline__ void done(const Unit&) const {}
};

__device__ __forceinline__ unsigned cvt_pk_bf16(float lo, float hi) { unsigned r; asm volatile("v_cvt_pk_bf16_f32 %0, %1, %2" : "=v"(r) : "v"(lo), "v"(hi)); return r; }
template <class Epi, class Sched, bool ALIGN_EPI = false, bool SP2 = false>
__device__ __forceinline__ void gemm_phase(PG8_LAS unsigned char* lds, const Gemm g, const Sched& S, const Epi& E) {
    const int tid = lt_tid(), wid = __builtin_amdgcn_readfirstlane(tid >> 6), lane = tid & 63, wr = wid >> 2, wc = wid & 3, fr = lane & 15, fq = lane >> 4;
    const int K = g.K, nt = K / BK;
    unsigned voffA[2], voffB[2];
#pragma unroll
    for (int i = 0; i < 2; ++i) { int R, C; stage_rc(tid * 16 + i * 8192, R, C); const int Rb = Epi::PERM ? ((R & ~31) + perm32(R & 31)) : R;
        voffA[i] = (unsigned)(R * K + C) * 2u; voffB[i] = (unsigned)(Rb * K + C) * 2u; }
    const size_t kstep = (size_t)(BK * 2);
    const size_t hstep = (size_t)HALF * K * 2;
    const size_t tstep = 2 * hstep;
    const unsigned ldsw = (unsigned)wid * 1024u;
    const int aoff = lds_byte(wr * 64 + fr, fq * 8), boff = lds_byte(wc * 32 + fr, fq * 8);
#define PG8_SA(b, h) (((b) * 2 + (h)) * HTB)
#define PG8_SB(b, h) ((4 + (b) * 2 + (h)) * HTB)
#define PG8_STAGE(bufoff, gbase, voff) do { _Pragma("unroll") for (int _i = 0; _i < 2; ++_i) \
        __builtin_amdgcn_global_load_lds((const unsigned*)((const char*)(gbase) + (voff)[_i]), (PG8_LAS unsigned*)(lds + (bufoff) + ldsw + _i * 8192), 16, 0, 0); } while (0)
#define PG8_LDA(dst, b, h) do { _Pragma("unroll") for (int m = 0; m < 4; ++m) _Pragma("unroll") for (int k = 0; k < 2; ++k) dst[m][k] = *(const PG8_LAS bf16x8*)(lds + PG8_SA(b, h) + aoff + m * 2048 + k * 1024); } while (0)
#define PG8_LDB(dst, b, h) do { _Pragma("unroll") for (int n = 0; n < 2; ++n) _Pragma("unroll") for (int k = 0; k < 2; ++k) dst[n][k] = *(const PG8_LAS bf16x8*)(lds + PG8_SB(b, h) + boff + n * 2048 + k * 1024); } while (0)
#define PG8_MMA(ai, bj, At, Bt) do { __builtin_amdgcn_s_setprio(1); _Pragma("unroll") for (int m = 0; m < 4; ++m) _Pragma("unroll") for (int n = 0; n < 2; ++n) _Pragma("unroll") for (int k = 0; k < 2; ++k) \
        acc[ai][bj][m][n] = __builtin_amdgcn_mfma_f32_16x16x32_bf16(Bt[n][k], At[m][k], acc[ai][bj][m][n], 0, 0, 0); __builtin_amdgcn_s_setprio(0); } while (0)
#define PG8_WAIT_V(n) asm volatile("s_waitcnt vmcnt(" #n ")" ::: "memory")
#define PG8_WAIT_L(n) asm volatile("s_waitcnt lgkmcnt(" #n ")" ::: "memory")
#define PG8_BAR __builtin_amdgcn_s_barrier()
#define PG8_SCHED __builtin_amdgcn_sched_barrier(0)
    Unit cur, nxt; int ui = 0;
    if (!S.next(0, cur)) return;
    f32x4 acc[2][2][4][2];
#pragma unroll
    for (int a = 0; a < 2; ++a)
#pragma unroll
        for (int b = 0; b < 2; ++b)
#pragma unroll
            for (int m = 0; m < 4; ++m)
#pragma unroll
                for (int n = 0; n < 2; ++n) acc[a][b][m][n] = (f32x4){0.f, 0.f, 0.f, 0.f};
    bf16x8 At[4][2], B0[2][2], B1[2][2];
    const char* cA = (const char*)g.A + (size_t)cur.pm * tstep; const char* cB = (const char*)g.Bt + (size_t)cur.pn * tstep;
    S.a_ready(cur);
    if constexpr (SP2) {
        PG8_STAGE(PG8_SB(0, 0), cB, voffB); PG8_STAGE(PG8_SB(0, 1), cB + hstep, voffB); PG8_STAGE(PG8_SA(0, 0), cA, voffA); PG8_STAGE(PG8_SA(0, 1), cA + hstep, voffA);
        if (wr == 1) PG8_BAR;
        PG8_WAIT_V(2); PG8_BAR;
        PG8_STAGE(PG8_SB(1, 0), cB + kstep, voffB); PG8_STAGE(PG8_SA(1, 0), cA + kstep, voffA); PG8_STAGE(PG8_SB(1, 1), cB + hstep + kstep, voffB);
        PG8_WAIT_V(6); PG8_BAR;
    } else {
        PG8_STAGE(PG8_SB(0, 0), cB, voffB); PG8_STAGE(PG8_SA(0, 0), cA, voffA); PG8_STAGE(PG8_SB(0, 1), cB + hstep, voffB); PG8_STAGE(PG8_SA(0, 1), cA + hstep, voffA);
        if (wr == 1) PG8_BAR;
        PG8_WAIT_V(4); PG8_BAR;
        PG8_STAGE(PG8_SB(1, 0), cB + kstep, voffB); PG8_STAGE(PG8_SA(1, 0), cA + kstep, voffA); PG8_STAGE(PG8_SB(1, 1), cB + hstep + kstep, voffB);
        PG8_WAIT_V(6); PG8_BAR;
    }
    for (;;) {
        const bool has_next = S.next(ui + 1, nxt);
        const char* nA = has_next ? (const char*)g.A + (size_t)nxt.pm * tstep : cA; const char* nB = has_next ? (const char*)g.Bt + (size_t)nxt.pn * tstep : cB;
        for (int t = 0; t < nt; t += 2) {
            const bool last = (t == nt - 2);
            const char* a1 = cA + (size_t)(t + 1) * kstep;
            const char* a2 = last ? nA : cA + (size_t)(t + 2) * kstep; const char* b2 = last ? nB : cB + (size_t)(t + 2) * kstep;
            const char* a3 = a2 + kstep; const char* b3 = b2 + kstep;
            if (last && has_next) S.a_ready(nxt);
            if constexpr (SP2) {
            PG8_LDB(B0, 0, 0); PG8_LDB(B1, 0, 1); PG8_SCHED; PG8_LDA(At, 0, 0); PG8_STAGE(PG8_SA(1, 1), a1 + hstep, voffA);
            PG8_WAIT_V(8); PG8_WAIT_L(0); PG8_BAR; PG8_MMA(0, 0, At, B0); PG8_MMA(0, 1, At, B1); PG8_BAR; PG8_SCHED;
            PG8_LDA(At, 0, 1); PG8_STAGE(PG8_SB(0, 0), b2, voffB); PG8_STAGE(PG8_SB(0, 1), b2 + hstep, voffB); PG8_STAGE(PG8_SA(0, 0), a2, voffA);
            PG8_WAIT_V(8); PG8_WAIT_L(0); PG8_BAR; PG8_MMA(1, 0, At, B0); PG8_MMA(1, 1, At, B1); PG8_BAR; PG8_SCHED;
            PG8_LDB(B0, 1, 0); PG8_LDB(B1, 1, 1); PG8_SCHED; PG8_LDA(At, 1, 0); PG8_STAGE(PG8_SA(0, 1), a2 + hstep, voffA);
            PG8_WAIT_V(8); PG8_WAIT_L(0); PG8_BAR; PG8_MMA(0, 0, At, B0); PG8_MMA(0, 1, At, B1); PG8_BAR; PG8_SCHED;
            PG8_LDA(At, 1, 1); PG8_STAGE(PG8_SB(1, 0), b3, voffB); PG8_STAGE(PG8_SB(1, 1), b3 + hstep, voffB); PG8_STAGE(PG8_SA(1, 0), a3, voffA);
            PG8_WAIT_V(8); PG8_WAIT_L(0); PG8_BAR; PG8_MMA(1, 0, At, B0); PG8_MMA(1, 1, At, B1); PG8_BAR; PG8_SCHED;
            } else {
            PG8_LDB(B0, 0, 0); PG8_SCHED; PG8_LDA(At, 0, 0); PG8_STAGE(PG8_SA(1, 1), a1 + hstep, voffA);
            PG8_WAIT_L(8); PG8_BAR; PG8_WAIT_L(0); PG8_MMA(0, 0, At, B0); PG8_BAR; PG8_SCHED;
            PG8_LDB(B1, 0, 1); PG8_STAGE(PG8_SB(0, 0), b2, voffB);
            PG8_BAR; PG8_WAIT_L(0); PG8_MMA(0, 1, At, B1); PG8_BAR;
            PG8_LDA(At, 0, 1); PG8_STAGE(PG8_SA(0, 0), a2, voffA);
            PG8_BAR; PG8_WAIT_L(0); PG8_MMA(1, 0, At, B0); PG8_BAR; PG8_SCHED;
            PG8_STAGE(PG8_SB(0, 1), b2 + hstep, voffB);
            PG8_WAIT_V(6); PG8_BAR; PG8_MMA(1, 1, At, B1); PG8_BAR;
            PG8_LDB(B0, 1, 0); PG8_SCHED; PG8_LDA(At, 1, 0); PG8_STAGE(PG8_SA(0, 1), a2 + hstep, voffA);
            PG8_WAIT_L(8); PG8_BAR; PG8_WAIT_L(0); PG8_MMA(0, 0, At, B0); PG8_BAR; PG8_SCHED;
            PG8_LDB(B1, 1, 1); PG8_STAGE(PG8_SB(1, 0), b3, voffB);
            PG8_BAR; PG8_WAIT_L(0); PG8_MMA(0, 1, At, B1); PG8_BAR;
            PG8_LDA(At, 1, 1); PG8_STAGE(PG8_SA(1, 0), a3, voffA);
            PG8_BAR; PG8_WAIT_L(0); PG8_MMA(1, 0, At, B0); PG8_BAR; PG8_SCHED;
            PG8_STAGE(PG8_SB(1, 1), b3 + hstep, voffB);
            PG8_WAIT_V(6); PG8_BAR; PG8_MMA(1, 1, At, B1); PG8_BAR;
            }
        }
        if constexpr (ALIGN_EPI) { if (wr == 0) PG8_BAR; }
        if constexpr (!Epi::AFTER_DRAIN) { E(acc, cur, wr, wc, fr, fq); S.done(cur); }
        if (!has_next) break;
#pragma unroll
        for (int a = 0; a < 2; ++a)
#pragma unroll
            for (int b = 0; b < 2; ++b)
#pragma unroll
                for (int m = 0; m < 4; ++m)
#pragma unroll
                    for (int n = 0; n < 2; ++n) acc[a][b][m][n] = (f32x4){0.f, 0.f, 0.f, 0.f};
        cur = nxt; cA = nA; cB = nB; ++ui;
        if constexpr (ALIGN_EPI) { if (wr == 1) PG8_BAR; }
    }
    PG8_WAIT_V(0);
    if constexpr (!ALIGN_EPI) { if (wr == 0) PG8_BAR; }
    PG8_BAR;
    if constexpr (Epi::AFTER_DRAIN) { E.fused(acc, cur, wr, wc, fr, fq, lds, wid, lane); S.done(cur); }
#undef PG8_SA
#undef PG8_SB
#undef PG8_STAGE
#undef PG8_LDA
#undef PG8_LDB
#undef PG8_MMA
#undef PG8_WAIT_V
#undef PG8_WAIT_L
#undef PG8_BAR
#undef PG8_SCHED
}
}

#define DI __device__ __forceinline__
#define LAS __attribute__((address_space(3)))
typedef unsigned short bf16_t;
typedef short bf16x8 __attribute__((ext_vector_type(8)));
typedef short s16x4 __attribute__((ext_vector_type(4)));
typedef float f32x4 __attribute__((ext_vector_type(4)));
typedef float f32x16 __attribute__((ext_vector_type(16)));
typedef unsigned u32x4 __attribute__((ext_vector_type(4)));
typedef unsigned u32x2 __attribute__((ext_vector_type(2)));

constexpr int DM = 1024, SEQ = 16384, NTP = 32768, NTS = 256, MTOT = 33024, DFF = 2816, NPROJ = 3328, NSEQ = 18, NMOD = 9216;
constexpr float EPS = 1e-6f, LOG2E = 1.4426950408889634f, C2 = 0.125f * LOG2E, NEGBIG = -1e30f;
constexpr int PC_QA = 0, PC_KA = 256, PC_VA = 512, PC_QB = 768, PC_KB = 896, PC_VB = 1024, PC_RB = 1280, PC_QC = 1536, PC_KC = 2048, PC_VC = 2560;
constexpr size_t O_FKP = 33816576, O_FVP = O_FKP + 16777216, O_FLP = O_FVP + 16777216, O_GSP = O_FLP + 262144, O_DKP = O_GSP + 32768, O_DVP = O_DKP + 33554432,
                 O_FKS = O_DVP + 33554432, O_FVS = O_FKS + 131072, O_FLS = O_FVS + 131072, O_GSS = O_FLS + 2048, O_DKS = O_GSS + 262144, O_DVS = O_DKS + 262144, O_END = O_DVS + 262144;
static_assert(O_END == 135825408, "output map");
constexpr size_t SZ_WFI1 = (size_t)5632 * 1024 * 2, SZ_WFO1 = (size_t)1024 * 2816 * 2, SZ_WIN1 = (size_t)3328 * 1024 * 2, SZ_WOUT1 = (size_t)1024 * 1024 * 2;
constexpr size_t WS_WFI = 0, WS_WFO = WS_WFI + 4 * SZ_WFI1, WS_WIN = WS_WFO + 4 * SZ_WFO1, WS_WOUT = WS_WIN + 2 * SZ_WIN1, WS_MOD = WS_WOUT + 2 * SZ_WOUT1;
constexpr size_t WS_LAM = WS_MOD + (size_t)2 * NSEQ * NMOD * 4, WS_H = WS_LAM + 1024, WS_UP = WS_H + (size_t)MTOT * 1024 * 2, WS_Y = WS_UP + (size_t)MTOT * NPROJ * 2;
constexpr size_t WS_PF = WS_Y, WS_CLOC = WS_PF + (size_t)MTOT * 32 * 4, WS_CTOT = WS_CLOC + (size_t)NTP * 4 * 4, WS_CB = WS_CTOT + 4096, WS_GU = WS_CB + (size_t)NTP * 128 * 4;
constexpr size_t WS_GS = WS_GU + (size_t)2048 * 2048 * 4, WS_GDEC = WS_GS + (size_t)2048 * 2048 * 4, WS_OSCR = WS_GDEC + (size_t)2048 * 32 * 4, WS_MIXEND = WS_OSCR + (size_t)2 * NTP * 512 * 2;
constexpr size_t WS_YS = WS_Y + (size_t)MTOT * 1024 * 4;
constexpr size_t WS_BAR = WS_YS + (size_t)8 * NTS * 1024 * 4;
constexpr size_t WS_END = WS_BAR + 16384;
static_assert(WS_MIXEND <= WS_YS && (WS_H % 256) == 0 && (WS_UP % 256) == 0 && (WS_Y % 256) == 0, "ws map");
constexpr int LDS_BYTES = 147456, LDS_XBST = 147456 - 112;

struct Args { const float* in[23]; float* out; unsigned char* ws; int nph; unsigned char plist[60]; };
static_assert(sizeof(Args) == 264, "Args has no padding");
enum { I_XP = 0, I_XS, I_CP, I_CS, I_CFK, I_CFV, I_CFL, I_SG, I_CDK, I_CDV, I_WADA, I_BADA, I_GN, I_WFI, I_WFO, I_WIN, I_BF, I_WGU, I_BGU, I_GGLA, I_GDIFF, I_LAMP, I_WOUT };

DI const float* ain_(const Args& a, int i) { asm volatile("" : "+s"(i)); return a.in[i]; }
#define AIN(a, i) ain_(a, i)
DI unsigned char* wsp_(const Args& a) { unsigned char* p = a.ws; asm volatile("" : "+s"(p)); return p; }
DI float* outp_(const Args& a) { float* p = a.out; asm volatile("" : "+s"(p)); return p; }
#define WSP(a) wsp_(a)
#define OUTP(a) outp_(a)
DI LAS unsigned char* lnd(LAS unsigned char* p) { asm volatile("" : "+s"(p)); return p; }
DI float one_minus_lam_init(int l) { const unsigned bits = (l == 0) ? 0x3f4ccccdu : 0x3f24fd5cu; return __uint_as_float(bits); }
DI float bf2f(bf16_t b) { return __uint_as_float((unsigned)b << 16); }
DI unsigned pk2(float lo, float hi) { return pg8::cvt_pk_bf16(lo, hi); }
DI float silu_f(float x) { return x / (1.f + __expf(-x)); }
DI float silu_fast(float x) { return x * __builtin_amdgcn_rcpf(1.f + __expf(-x)); }
DI float logsig(float x) { return fminf(x, 0.f) - log1pf(__expf(-fabsf(x))); }
DI float wave_sum(float v) {
#pragma unroll
    for (int o = 1; o < 64; o <<= 1) v += __shfl_xor(v, o);
    return v;
}
DI float wave_max(float v) {
#pragma unroll
    for (int o = 1; o < 64; o <<= 1) v = fmaxf(v, __shfl_xor(v, o));
    return v;
}
DI float half_max(float v) { auto rr = __builtin_amdgcn_permlane32_swap(__float_as_uint(v), __float_as_uint(v), false, false); return fmaxf(__uint_as_float(rr[0]), __uint_as_float(rr[1])); }
DI float half_sum(float v) { auto rr = __builtin_amdgcn_permlane32_swap(__float_as_uint(v), __float_as_uint(v), false, false); return __uint_as_float(rr[0]) + __uint_as_float(rr[1]); }
DI int seq_of(int m) { return m < NTP ? (m >> 14) : 2 + ((m - NTP) >> 4); }
DI int crow(int r, int hi) { return (r & 3) + 8 * (r >> 2) + 4 * hi; }

struct EpiSwiglu {
    static constexpr bool PERM = true, AFTER_DRAIN = false;
    bf16_t* U;
    DI void operator()(const pg8::f32x4 (&acc)[2][2][4][2], const pg8::Unit& u, int wr, int wc, int fr, int fq) const {
        const int row0 = u.pm * 256 + wr * 64 + fr, col0 = u.pn * 128 + wc * 32 + 8 * fq;
#pragma unroll
        for (int ai = 0; ai < 2; ++ai)
#pragma unroll
            for (int m = 0; m < 4; ++m) {
                const pg8::f32x4 g0 = acc[ai][0][m][0], g1 = acc[ai][0][m][1], u0 = acc[ai][1][m][0], u1 = acc[ai][1][m][1];
                u32x4 w;
                w.x = pk2(silu_fast(g0[0]) * u0[0], silu_fast(g0[1]) * u0[1]); w.y = pk2(silu_fast(g0[2]) * u0[2], silu_fast(g0[3]) * u0[3]);
                w.z = pk2(silu_fast(g1[0]) * u1[0], silu_fast(g1[1]) * u1[1]); w.w = pk2(silu_fast(g1[2]) * u1[2], silu_fast(g1[3]) * u1[3]);
                *(u32x4*)(U + (size_t)(row0 + ai * 128 + m * 16) * DFF + col0) = w;
            }
    }
};
struct EpiF32 {
    static constexpr bool PERM = true, AFTER_DRAIN = false;
    bf16_t* Y;
    DI void operator()(const pg8::f32x4 (&acc)[2][2][4][2], const pg8::Unit& u, int wr, int wc, int fr, int fq) const {
        const int row0 = u.pm * 256 + wr * 64 + fr, col0 = u.pn * 256 + wc * 32 + 8 * fq;
#pragma unroll
        for (int ai = 0; ai < 2; ++ai)
#pragma unroll
            for (int m = 0; m < 4; ++m) {
                bf16_t* rp = Y + (size_t)(row0 + ai * 128 + m * 16) * DM + col0;
#pragma unroll
                for (int bj = 0; bj < 2; ++bj) { const pg8::f32x4 v0 = acc[ai][bj][m][0], v1 = acc[ai][bj][m][1];
                    u32x4 w; w.x = pk2(v0[0], v0[1]); w.y = pk2(v0[2], v0[3]); w.z = pk2(v1[0], v1[1]); w.w = pk2(v1[2], v1[3]);
                    *(u32x4*)(rp + bj * 128) = w; }
            }
    }
};
struct EpiProj {
    static constexpr bool PERM = true, AFTER_DRAIN = false;
    bf16_t* P; float* out; float* PF; int l;
    DI void operator()(const pg8::f32x4 (&acc)[2][2][4][2], const pg8::Unit& u, int wr, int wc, int fr, int fq) const {
        const int pn = u.pn; const bool samp = (u.pm == 128);
        float* dst = nullptr; int W = 0, cbase = 0;
        if (pn == 1) { dst = out + (samp ? O_FKS : O_FKP); W = 256; }
        else if (pn == 2) { dst = out + (samp ? O_FVS : O_FVP); W = 256; }
        else if (pn == 8 || pn == 9) { dst = out + (samp ? O_DKS : O_DKP); W = 512; cbase = (pn - 8) * 256; }
        else if (pn == 10 || pn == 11) { dst = out + (samp ? O_DVS : O_DVP); W = 512; cbase = (pn - 10) * 256; }
        const size_t lrows = samp ? (size_t)l * NTS : (size_t)l * NTP; const int rbase = samp ? NTP : 0;
#pragma unroll
        for (int ai = 0; ai < 2; ++ai)
#pragma unroll
            for (int m = 0; m < 4; ++m) {
                const int row = u.pm * 256 + ai * 128 + wr * 64 + m * 16 + fr;
#pragma unroll
                for (int bj = 0; bj < 2; ++bj) {
                    const int ct = bj * 128 + wc * 32 + 8 * fq;
                    const pg8::f32x4 v0 = acc[ai][bj][m][0], v1 = acc[ai][bj][m][1];
                    u32x4 w; w.x = pk2(v0[0], v0[1]); w.y = pk2(v0[2], v0[3]); w.z = pk2(v1[0], v1[1]); w.w = pk2(v1[2], v1[3]);
                    *(u32x4*)(P + (size_t)row * NPROJ + pn * 256 + ct) = w;
                    if (dst) { float* d = dst + (lrows + (size_t)(row - rbase)) * W + cbase + ct; *(f32x4*)d = v0; *(f32x4*)(d + 4) = v1; }
                    if (pn == 12 && ct < 32) { float* d = PF + (size_t)row * 32 + ct; *(f32x4*)d = v0; *(f32x4*)(d + 4) = v1; }
                }
            }
    }
};

DI int srccol(int mode, int d) {
    if (mode == 0) return d;
    if (mode == 1) { const int t = d >> 8, w = d & 255; return w < 128 ? t * 128 + w : DFF + t * 128 + (w - 128); }
    if (d < 768) return d;
    if (d < 1280) return d + 4;
    if (d < 3072) return d + 20;
    if (d < 3076) return 768 + (d - 3072);
    if (d < 3092) return 1284 + (d - 3076);
    return -1;
}
DI void tr_item(const float* W, int K, int Nsrc, bf16_t* WT, int mode, LAS float* scr, int kb, int db, int lane) {
    const int k0 = 64 * kb, d0 = 32 * db, sc = srccol(mode, d0 + (lane & 31));
#pragma unroll 16
    for (int i = 0; i < 32; ++i) { const int kk = 2 * i + (lane >> 5); scr[kk * 33 + (lane & 31)] = sc >= 0 ? W[(size_t)(k0 + kk) * Nsrc + sc] : 0.f; }
    asm volatile("s_waitcnt lgkmcnt(0)" ::: "memory");
    const int c = lane & 7;
#pragma unroll
    for (int j = 0; j < 4; ++j) { const int n = (lane >> 3) + 8 * j; const LAS float* s = scr + (8 * c) * 33 + n;
        u32x4 o; o.x = pk2(s[0 * 33], s[1 * 33]); o.y = pk2(s[2 * 33], s[3 * 33]); o.z = pk2(s[4 * 33], s[5 * 33]); o.w = pk2(s[6 * 33], s[7 * 33]);
        *(u32x4*)(WT + (size_t)(d0 + n) * K + k0 + 8 * c) = o; }
    asm volatile("s_waitcnt lgkmcnt(0)" ::: "memory");
}
constexpr int TR_I_FI = 16 * 176, TR_I_FO = 44 * 32, TR_I_IN = 16 * 104, TR_I_OUT = 16 * 32;
constexpr int TR_ITEMS_PER_LAYER = 2 * TR_I_FI + 2 * TR_I_FO + TR_I_IN + TR_I_OUT;
DI void tr_layer_item(const Args& a, LAS unsigned char* lds, int layer, int r, int wave, int lane) {
    LAS float* scr = (LAS float*)(lds) + wave * (64 * 33); unsigned char* ws = WSP(a);
    if (r < 2 * TR_I_FI) { const int mi = layer * 2 + r / TR_I_FI, q = r % TR_I_FI; tr_item(AIN(a, I_WFI) + (size_t)mi * 1024 * 5632, 1024, 5632, (bf16_t*)(ws + WS_WFI + mi * SZ_WFI1), 1, scr, q / 176, q % 176, lane); return; }
    r -= 2 * TR_I_FI;
    if (r < 2 * TR_I_FO) { const int mi = layer * 2 + r / TR_I_FO, q = r % TR_I_FO; tr_item(AIN(a, I_WFO) + (size_t)mi * 2816 * 1024, 2816, 1024, (bf16_t*)(ws + WS_WFO + mi * SZ_WFO1), 0, scr, q / 32, q % 32, lane); return; }
    r -= 2 * TR_I_FO;
    if (r < TR_I_IN) { tr_item(AIN(a, I_WIN) + (size_t)layer * 1024 * 3092, 1024, 3092, (bf16_t*)(ws + WS_WIN + layer * SZ_WIN1), 2, scr, r / 104, r % 104, lane); return; }
    r -= TR_I_IN;
    tr_item(AIN(a, I_WOUT) + (size_t)layer * 1024 * 1024, 1024, 1024, (bf16_t*)(ws + WS_WOUT + layer * SZ_WOUT1), 0, scr, r / 32, r % 32, lane);
}
DI void phase_prologue(const Args& a, LAS unsigned char* lds) {
    const int tid = lt_tid(), lane = tid & 63, wave = tid >> 6;
    unsigned char* ws = WSP(a);
    {
        LAS float* sc = (LAS float*)lds; LAS float* red = sc + NSEQ * 1024;
        bool have = false;
        for (int item = blockIdx.x; item < 576; item += gridDim.x) {
            if (!have) {
                for (int i = tid; i < NSEQ * 1024; i += 512) { const int s = i >> 10, k = i & 1023; const float c = s < 2 ? AIN(a, I_CP)[s * 1024 + k] : AIN(a, I_CS)[(s - 2) * 1024 + k]; sc[i] = silu_f(c); }
                have = true; __syncthreads();
            }
            const int l = item / 288, n0 = (item % 288) * 32, c4 = tid & 7, kg = tid >> 3;
            f32x4 acc[NSEQ];
#pragma unroll
            for (int s = 0; s < NSEQ; ++s) acc[s] = (f32x4){0.f, 0.f, 0.f, 0.f};
            const float* wp = AIN(a, I_WADA) + ((size_t)l * 1024 + kg * 16) * NMOD + n0 + 4 * c4;
#pragma unroll 8
            for (int k = 0; k < 16; ++k) { const f32x4 w = *(const f32x4*)(wp + (size_t)k * NMOD);
#pragma unroll
                for (int s = 0; s < NSEQ; ++s) acc[s] = acc[s] + w * sc[s * 1024 + kg * 16 + k]; }
#pragma unroll
            for (int s = 0; s < NSEQ; ++s)
#pragma unroll
                for (int c = 0; c < 4; ++c) { float v = acc[s][c]; v += __shfl_xor(v, 8); v += __shfl_xor(v, 16); v += __shfl_xor(v, 32); acc[s][c] = v; }
            if ((tid & 63) < 8) {
#pragma unroll
                for (int s = 0; s < NSEQ; ++s) *(LAS f32x4*)(red + ((tid >> 6) * NSEQ + s) * 32 + 4 * c4) = acc[s]; }
            __syncthreads();
            float* MOD = (float*)(ws + WS_MOD);
            for (int i = tid; i < NSEQ * 32; i += 512) { const int s = i >> 5, c = i & 31; float v = AIN(a, I_BADA)[l * NMOD + n0 + c];
#pragma unroll
                for (int g = 0; g < 8; ++g) v += red[(g * NSEQ + s) * 32 + c];
                MOD[((size_t)l * NSEQ + s) * NMOD + n0 + c] = v; }
            __syncthreads();
        }
        __syncthreads();
    }
    if (blockIdx.x == 0 && tid < 2) { const float* lp = AIN(a, I_LAMP) + tid * 256; float s0 = 0.f, s1 = 0.f;
        for (int i = 0; i < 64; ++i) { s0 += lp[i] * lp[64 + i]; s1 += lp[128 + i] * lp[192 + i]; }
        const float lam_init = 0.8f - 0.6f * expf(-0.3f * (float)tid);
        ((float*)(ws + WS_LAM))[tid] = expf(s0) - expf(s1) + lam_init; }
    if (blockIdx.x == 0 && tid >= 64 && tid < 64 + 112) ((unsigned*)(ws + WS_LAM))[16 + tid - 64] = 0u;
    const int gw = blockIdx.x * 8 + wave, NGW = gridDim.x * 8;
    for (int it = gw; it < 2 * TR_ITEMS_PER_LAYER; it += NGW) tr_layer_item(a, lds, it >= TR_ITEMS_PER_LAYER ? 1 : 0, it % TR_ITEMS_PER_LAYER, wave, lane);
}

struct RowVecs { f32x4 gpo[4], gpr[4], m2[4], m0[4], m1[4]; int cur_sq; };
DI void rows_load(const Args& a, int m, bool first, bool post, int lane, f32x4 (&x)[4], u32x2 (&y)[4]) {
    const float* xs = first ? (m < NTP ? AIN(a, I_XP) + (size_t)m * DM : AIN(a, I_XS) + (size_t)(m - NTP) * DM) : OUTP(a) + (size_t)m * DM;
#pragma unroll
    for (int j = 0; j < 4; ++j) x[j] = *(const f32x4*)(xs + 4 * lane + 256 * j);
    if (post) { const bf16_t* yr = (const bf16_t*)(WSP(a) + WS_Y) + (size_t)m * DM;
#pragma unroll
        for (int j = 0; j < 4; ++j) y[j] = *(const u32x2*)(yr + 4 * lane + 256 * j); }
}
DI void rows_process(const Args& a, int m, int l, int post_s, float res_w, int pre_s, int pre_l, int lane, f32x4 (&x)[4], const u32x2 (&yw)[4], RowVecs& V) {
    const int sq = seq_of(m);
    if (sq != V.cur_sq) { V.cur_sq = sq; const float* MOD = (const float*)(WSP(a) + WS_MOD);
        if (post_s >= 0) { const float* p2 = MOD + ((size_t)l * NSEQ + sq) * NMOD + (post_s * 3 + 2) * DM;
#pragma unroll
            for (int j = 0; j < 4; ++j) V.m2[j] = *(const f32x4*)(p2 + 4 * lane + 256 * j); }
        if (pre_s >= 0) { const float* mb = MOD + ((size_t)pre_l * NSEQ + sq) * NMOD + (pre_s * 3) * DM;
#pragma unroll
            for (int j = 0; j < 4; ++j) { V.m0[j] = *(const f32x4*)(mb + 4 * lane + 256 * j); V.m1[j] = *(const f32x4*)(mb + DM + 4 * lane + 256 * j); } } }
    if (post_s >= 0) {
        f32x4 y[4]; float ss = 0.f;
#pragma unroll
        for (int j = 0; j < 4; ++j) { y[j] = (f32x4){__uint_as_float(yw[j].x << 16), __uint_as_float(yw[j].x & 0xffff0000u), __uint_as_float(yw[j].y << 16), __uint_as_float(yw[j].y & 0xffff0000u)};
            if (m >= NTP) { const float* ys = (const float*)(WSP(a) + WS_YS) + (size_t)(m - NTP) * DM + 4 * lane + 256 * j; y[j] = *(const f32x4*)ys;
#pragma unroll
                for (int ks = 1; ks < 8; ++ks) y[j] = y[j] + *(const f32x4*)(ys + (size_t)ks * NTS * DM); }
            ss += (y[j].x * y[j].x + y[j].y * y[j].y) + (y[j].z * y[j].z + y[j].w * y[j].w); }
        const float ry = rsqrtf(wave_sum(ss) * (1.f / DM) + EPS) * res_w;
#pragma unroll
        for (int j = 0; j < 4; ++j) x[j] = x[j] + V.m2[j] * (y[j] * ry * V.gpo[j]);
        float* xd = OUTP(a) + (size_t)m * DM;
#pragma unroll
        for (int j = 0; j < 4; ++j) *(f32x4*)(xd + 4 * lane + 256 * j) = x[j];
    }
    if (pre_s >= 0) {
        float ss = 0.f;
#pragma unroll
        for (int j = 0; j < 4; ++j) ss += (x[j].x * x[j].x + x[j].y * x[j].y) + (x[j].z * x[j].z + x[j].w * x[j].w);
        const float rx = rsqrtf(wave_sum(ss) * (1.f / DM) + EPS);
        bf16_t* hr = (bf16_t*)(WSP(a) + WS_H) + (size_t)m * DM;
#pragma unroll
        for (int j = 0; j < 4; ++j) { const f32x4 hv = (x[j] * rx * V.gpr[j]) * (V.m1[j] + 1.f) + V.m0[j]; u32x2 w; w.x = pk2(hv.x, hv.y); w.y = pk2(hv.z, hv.w); *(u32x2*)(hr + 4 * lane + 256 * j) = w; }
    }
}
DI void phase_rows(const Args& a, int l, int post_s, float res_w, int pre_s, int pre_l, bool first) {
    const int tid = lt_tid(), lane = tid & 63, wave = tid >> 6;
    const int gw = blockIdx.x * 8 + wave, NGW = gridDim.x * 8;
    RowVecs V; V.cur_sq = -1;
#pragma unroll
    for (int j = 0; j < 4; ++j) { V.gpo[j] = V.gpr[j] = V.m2[j] = V.m0[j] = V.m1[j] = (f32x4){0.f, 0.f, 0.f, 0.f}; }
    if (post_s >= 0) { const float* g = AIN(a, I_GN) + (size_t)(l * 6 + 2 * post_s + 1) * DM;
#pragma unroll
        for (int j = 0; j < 4; ++j) V.gpo[j] = *(const f32x4*)(g + 4 * lane + 256 * j); }
    if (pre_s >= 0) { const float* g = AIN(a, I_GN) + (size_t)(pre_l * 6 + 2 * pre_s) * DM;
#pragma unroll
        for (int j = 0; j < 4; ++j) V.gpr[j] = *(const f32x4*)(g + 4 * lane + 256 * j); }
    constexpr int NR = 4;
    for (int m0 = gw; m0 < MTOT; m0 += NR * NGW) {
        f32x4 x[NR][4]; u32x2 y[NR][4];
#pragma unroll
        for (int r = 0; r < NR; ++r)
#pragma unroll
            for (int j = 0; j < 4; ++j) { y[r][j] = (u32x2){0u, 0u}; x[r][j] = (f32x4){0.f, 0.f, 0.f, 0.f}; }
#pragma unroll
        for (int r = 0; r < NR; ++r) if (m0 + r * NGW < MTOT) rows_load(a, m0 + r * NGW, first, post_s >= 0, lane, x[r], y[r]);
#pragma unroll
        for (int r = 0; r < NR; ++r) if (m0 + r * NGW < MTOT) rows_process(a, m0 + r * NGW, l, post_s, res_w, pre_s, pre_l, lane, x[r], y[r], V);
    }
}
#define XB_TMO      128
#define XB_XCNT(j)  (256  + 64 * (j))
#define XB_XSUB(j)  (1280 + 64 * (j))
#define XB_XGEN(j)  (2304 + 64 * (j))
#define XB_TOP      3328
#define XB_TOPGEN   3392
#define XCD_BAR_WORDS 3456
#define XB_SPIN_CAP (1u << 18)

__device__ __forceinline__ unsigned xb_ld(unsigned* p)              { return __hip_atomic_load(p, __ATOMIC_RELAXED, __HIP_MEMORY_SCOPE_AGENT); }
__device__ __forceinline__ unsigned xb_add(unsigned* p, unsigned v) { return __hip_atomic_fetch_add(p, v, __ATOMIC_RELAXED, __HIP_MEMORY_SCOPE_AGENT); }
__device__ __forceinline__ unsigned xb_xcc_id() { return (unsigned)__builtin_amdgcn_s_getreg((3 << 11) | 20) & 0xFu; }
#define XB_SPIN(cond, bar) do { unsigned _sp = 0; while (cond) { __builtin_amdgcn_s_sleep(1); \
    if ((++_sp & 255u) == 0u) { if (xb_ld(&(bar)[XB_TMO])) break; if (_sp > XB_SPIN_CAP) { atomicAdd(&(bar)[XB_TMO], 1u); break; } } } } while (0)

struct XcdBarrier {
    unsigned* bar; unsigned x;
    volatile LAS unsigned* st;
};

__device__ __forceinline__ XcdBarrier xcd_barrier_post(unsigned* bar, volatile LAS unsigned* st) {
    XcdBarrier b; b.bar = bar; b.x = xb_xcc_id(); b.st = st;
    if (lt_tid() == 0) (void)xb_add(&bar[XB_XCNT(b.x)], 1u);
    return b;
}
__device__ __forceinline__ void xcd_barrier_complete(unsigned* bar, unsigned x, unsigned& nloc, unsigned& nx) {
    const unsigned G = gridDim.x * gridDim.y * gridDim.z;
    unsigned sum, cnt, mine, sp = 0u;
    for (;;) {
        sum = 0u; cnt = 0u; mine = 0u;
#pragma unroll
        for (unsigned j = 0; j < 16; ++j) { const unsigned c = xb_ld(&bar[XB_XCNT(j)]); sum += c; cnt += (c > 0u) ? 1u : 0u; mine = (j == x) ? c : mine; }
        if (sum == G) break;
        __builtin_amdgcn_s_sleep(1);
        if ((++sp & 255u) == 0u) { if (xb_ld(&bar[XB_TMO])) break; if (sp > XB_SPIN_CAP) { atomicAdd(&bar[XB_TMO], 1u); break; } }
    }
    nloc = mine > 0u ? mine : 1u; nx = cnt > 0u ? cnt : 1u;
}

__device__ __forceinline__ void xcd_barrier(const XcdBarrier& b) {
    asm volatile("s_waitcnt vmcnt(0)" ::: "memory");
    __syncthreads();
    if (lt_tid() == 0) {
        unsigned* bar = b.bar;
        __builtin_amdgcn_s_waitcnt(0);
        unsigned nloc = b.st[0], nx = b.st[1];
        if (nloc == 0u) { xcd_barrier_complete(bar, b.x, nloc, nx); b.st[0] = nloc; b.st[1] = nx; }
        const unsigned old = xb_add(&bar[XB_XSUB(b.x)], 1u);
        const unsigned gen = old / nloc;
        if (old + 1u == (gen + 1u) * nloc) {
            __builtin_amdgcn_fence(__ATOMIC_RELEASE, "agent");
            asm volatile("s_waitcnt vmcnt(0)" ::: "memory");
            const unsigned og = xb_add(&bar[XB_TOP], 1u);
            const unsigned tg = og / nx;
            if (og + 1u == (tg + 1u) * nx) xb_add(&bar[XB_TOPGEN], 1u);
            else XB_SPIN(xb_ld(&bar[XB_TOPGEN]) == tg, bar);
            __builtin_amdgcn_fence(__ATOMIC_ACQUIRE, "agent");
            xb_add(&bar[XB_XGEN(b.x)], 1u);
            asm volatile("s_waitcnt vmcnt(0)" ::: "memory");
        } else {
            XB_SPIN(xb_ld(&bar[XB_XGEN(b.x)]) == gen, bar);
            __builtin_amdgcn_fence(__ATOMIC_ACQUIRE, "agent");
            asm volatile("s_waitcnt vmcnt(0)" ::: "memory");
        }
    }
    __syncthreads();
}

constexpr int KP = 144;
constexpr int AT_K = 0, AT_V = 64 * KP, AT_B = AT_V + 64 * 272, AT_BUF = AT_B + 256;
static_assert(4 * AT_BUF + 64 <= LDS_BYTES - 128 && (AT_BUF % 16) == 0, "attention LDS");
typedef short v4i16_t __attribute__((ext_vector_type(4)));
DI s16x4 vtr(const LAS unsigned char* p) { return __builtin_bit_cast(s16x4, __builtin_amdgcn_ds_read_tr16_b64_v4i16((LAS v4i16_t*)p)); }

template <int DV, bool FOX, int HH>
DI void attn_pass(LAS unsigned char* lds, const bf16_t* __restrict__ P, size_t rowbase, int q0, int qcol, int kcol, int vcol,
                  const float* __restrict__ cloc, const float* __restrict__ ctot_b, int h, float sb, f32x16 (&O)[DV / 32], float& l_out) {
    constexpr float slope_l2 = (HH == 0 ? 0.25f : HH == 1 ? 0.0625f : HH == 2 ? 0.015625f : 0.00390625f) * LOG2E;
    constexpr int VP = DV * 2 + 16, NVR = DV / 64;
    lds = lnd(lds);
    const int tid = lt_tid(), lane = tid & 63, w = __builtin_amdgcn_readfirstlane(tid >> 6), r32 = lane & 31, hi = lane >> 5;
    const int qrow = q0 + 32 * w + r32;
    bf16x8 qf[4];
    { const bf16_t* qp = P + (rowbase + qrow) * NPROJ + qcol + 8 * hi;
#pragma unroll
      for (int d0 = 0; d0 < 4; ++d0) qf[d0] = *(const bf16x8*)(qp + 16 * d0); }
    const int tmax_wg = (q0 >> 6) + 3, tmax_w = (q0 >> 6) + (w >> 1);
    float mrun = NEGBIG, lrun = 0.f;
    float ubase;
    { float qs = 0.f;
#pragma unroll
      for (int d0 = 0; d0 < 4; ++d0)
#pragma unroll
          for (int j = 0; j < 8; ++j) { const float v = bf2f((bf16_t)qf[d0][j]); qs += v * v; }
      qs = half_sum(qs); ubase = sb * wave_max(sqrtf(qs)) * 1.01f + 30.1f;
      ubase = __uint_as_float(__builtin_amdgcn_readfirstlane(__float_as_uint(ubase))); }
    bool done = false;
    const float hterm = FOX ? 0.f : slope_l2 * 4.f * (float)hi;
    LAS int* flags = (LAS int*)(lds + 4 * AT_BUF);
#pragma unroll
    for (int db = 0; db < DV / 32; ++db)
#pragma unroll
        for (int r = 0; r < 16; ++r) O[db][r] = 0.f;
    const int srow = tid >> 3, sch = tid & 7;
    u32x4 kregA, vregA[NVR], kregB, vregB[NVR]; float bregA = 0.f, bregB = 0.f; float Drun = 0.f; int kt_cur = q0 >> 8;
#define AT_ISSUE(S, t) do { const bf16_t* rp = P + (rowbase + 64 * (t) + srow) * NPROJ; \
        kreg##S = *(const u32x4*)(rp + kcol + 8 * sch); \
        _Pragma("unroll") for (int i_ = 0; i_ < NVR; ++i_) vreg##S[i_] = *(const u32x4*)(rp + vcol + 8 * (sch + 8 * i_)); \
        if (FOX) { const int kt_ = (t) >> 2; if (kt_ != kt_cur) { Drun += ctot_b[kt_ * 4 + h]; kt_cur = kt_; } \
                   if (tid < 64) breg##S = (Drun - cloc[(rowbase + 64 * (t) + tid) * 4 + h]) * LOG2E; } } while (0)
    AT_ISSUE(A, tmax_wg); AT_ISSUE(B, tmax_wg - 1);
    int it = 0, t = tmax_wg;
    for (;;) {
      {
        const int pr = it >> 1;
        LAS unsigned char* bufA = lds + ((pr & 1) * 2) * AT_BUF; LAS unsigned char* bufB = bufA + AT_BUF;
        *(LAS u32x4*)(bufA + AT_K + srow * KP + sch * 16) = kregA;
#pragma unroll
        for (int i = 0; i < NVR; ++i) *(LAS u32x4*)(bufA + AT_V + srow * VP + (sch + 8 * i) * 16) = vregA[i];
        if (FOX) { if (tid < 64) *(LAS float*)(bufA + AT_B + tid * 4) = bregA; }
        *(LAS u32x4*)(bufB + AT_K + srow * KP + sch * 16) = kregB;
#pragma unroll
        for (int i = 0; i < NVR; ++i) *(LAS u32x4*)(bufB + AT_V + srow * VP + (sch + 8 * i) * 16) = vregB[i];
        if (FOX) { if (tid < 64) *(LAS float*)(bufB + AT_B + tid * 4) = bregB; }
        asm volatile("s_waitcnt lgkmcnt(0)" ::: "memory"); __builtin_amdgcn_s_barrier(); asm volatile("" ::: "memory");
        if (pr > 0) { const LAS int* fl = flags + ((pr - 1) & 1) * 8; int all = 1;
#pragma unroll
            for (int i = 0; i < 8; ++i) all &= fl[i];
            if (all) break; }
        if (t > 1) AT_ISSUE(A, t - 2);
        if (t > 2) AT_ISSUE(B, t - 3);
        { LAS unsigned char* buf = bufA;
        if (t <= tmax_w && !done) {
            const float bmax = FOX ? ((const LAS float*)(buf + AT_B))[63] : slope_l2 * (float)(64 * t + 63 - q0);
            if (__all(ubase + bmax < mrun)) done = true;
        }
        if (t <= tmax_w && !done) {
            const float base_t = FOX ? 0.f : slope_l2 * (float)(64 * t - q0); float c32 = 0.f, hadd = 0.f;
            f32x16 s0, s1;
#pragma unroll
            for (int r = 0; r < 16; ++r) { s0[r] = 0.f; s1[r] = 0.f; }
            const LAS unsigned char* kb = buf + AT_K + r32 * KP + hi * 16;
            const LAS unsigned char* vb = buf + AT_V + (4 * hi + ((lane & 15) >> 2)) * VP + (16 * ((lane >> 4) & 1) + 4 * (lane & 3)) * 2;
            bf16x8 kf[8];
#pragma unroll
            for (int d0 = 0; d0 < 4; ++d0) { kf[2 * d0] = *(const LAS bf16x8*)(kb + d0 * 32); kf[2 * d0 + 1] = *(const LAS bf16x8*)(kb + 32 * KP + d0 * 32); }
            __builtin_amdgcn_sched_barrier(0);
#pragma unroll
            for (int d0 = 0; d0 < 4; ++d0) {
                s0 = __builtin_amdgcn_mfma_f32_32x32x16_bf16(kf[2 * d0], qf[d0], s0, 0, 0, 0);
                s1 = __builtin_amdgcn_mfma_f32_32x32x16_bf16(kf[2 * d0 + 1], qf[d0], s1, 0, 0, 0);
            }
            s16x4 vfa[8], vfb[8];
#define AT_RDV(dst, db) do { _Pragma("unroll") for (int ks_ = 0; ks_ < 4; ++ks_) { dst[2 * ks_] = vtr(vb + (16 * ks_) * VP + (db) * 64); dst[2 * ks_ + 1] = vtr(vb + (16 * ks_ + 8) * VP + (db) * 64); } } while (0)
            if (FOX) {
                const LAS float* bb = (const LAS float*)(buf + AT_B);
#pragma unroll
                for (int g = 0; g < 4; ++g) { const f32x4 b0 = *(const LAS f32x4*)(bb + 8 * g + 4 * hi), b1 = *(const LAS f32x4*)(bb + 32 + 8 * g + 4 * hi);
#pragma unroll
                    for (int j = 0; j < 4; ++j) { s0[4 * g + j] = s0[4 * g + j] * C2 + b0[j]; s1[4 * g + j] = s1[4 * g + j] * C2 + b1[j]; } }
                if (t == tmax_w) { const int qil = 32 * (w & 1) + r32;
#pragma unroll
                    for (int r = 0; r < 16; ++r) { const int j0 = crow(r, hi); if (j0 > qil) s0[r] = NEGBIG; if (j0 + 32 > qil) s1[r] = NEGBIG; } }
            } else {
                if (t == tmax_w) { const int il = qrow - 64 * t;
#pragma unroll
                    for (int r = 0; r < 16; ++r) { const int j0 = crow(r, hi), j1 = j0 + 32;
                        s0[r] = s0[r] * C2 + slope_l2 * (float)(j0 > il ? 2 * il - j0 : j0); s1[r] = s1[r] * C2 + slope_l2 * (float)(j1 > il ? 2 * il - j1 : j1); }
                } else {
#pragma unroll
                    for (int r = 0; r < 16; ++r) { const float cc = slope_l2 * (float)crow(r, 0); s0[r] = s0[r] * C2 + cc; s1[r] = s1[r] * C2 + cc; }
                    c32 = 32.f * slope_l2; hadd = hterm;
                }
            }
            float mx0 = s0[0], mx1 = s1[0];
#pragma unroll
            for (int r = 1; r < 16; ++r) { mx0 = fmaxf(mx0, s0[r]); mx1 = fmaxf(mx1, s1[r]); }
            float mx = fmaxf(mx0, mx1 + c32) + hadd;
            mx = half_max(mx) + base_t;
            const float mnew = fmaxf(mrun, mx), msub = mnew - base_t - hadd, msub1 = msub - c32;
            if (__any(mnew > mrun)) { const float alpha = __builtin_amdgcn_exp2f(mrun - mnew); lrun *= alpha;
#pragma unroll
                for (int db = 0; db < DV / 32; ++db)
#pragma unroll
                    for (int r = 0; r < 16; ++r) O[db][r] *= alpha; }
            mrun = mnew;
#define AT_RDH(dst, dp, kh) do { _Pragma("unroll") for (int d_ = 0; d_ < 2; ++d_) _Pragma("unroll") for (int k_ = 0; k_ < 2; ++k_) { \
                dst[d_ * 4 + k_ * 2] = vtr(vb + (16 * (2 * (kh) + k_)) * VP + (2 * (dp) + d_) * 64); dst[d_ * 4 + k_ * 2 + 1] = vtr(vb + (16 * (2 * (kh) + k_) + 8) * VP + (2 * (dp) + d_) * 64); } } while (0)
#define AT_PVH(cur, dp, kh) do { _Pragma("unroll") for (int d_ = 0; d_ < 2; ++d_) _Pragma("unroll") for (int k_ = 0; k_ < 2; ++k_) { \
                const s16x4 lo_ = cur[d_ * 4 + k_ * 2], hi_ = cur[d_ * 4 + k_ * 2 + 1]; \
                const bf16x8 vf_ = (bf16x8){lo_[0], lo_[1], lo_[2], lo_[3], hi_[0], hi_[1], hi_[2], hi_[3]}; \
                O[2 * (dp) + d_] = __builtin_amdgcn_mfma_f32_32x32x16_bf16(vf_, __builtin_bit_cast(bf16x8, pw[2 * (kh) + k_]), O[2 * (dp) + d_], 0, 0, 0); } } while (0)
            __builtin_amdgcn_sched_barrier(0);
            AT_RDH(vfa, 0, 0);
            __builtin_amdgcn_sched_barrier(0);
            float ps = 0.f; u32x4 pw[4];
#pragma unroll
            for (int r = 0; r < 16; ++r) { s0[r] = __builtin_amdgcn_exp2f(s0[r] - msub); ps += s0[r]; }
#pragma unroll
            for (int i = 0; i < 4; ++i) { pw[0][i] = pk2(s0[2 * i], s0[2 * i + 1]); pw[1][i] = pk2(s0[8 + 2 * i], s0[8 + 2 * i + 1]); }
            __builtin_amdgcn_sched_barrier(0);
            if constexpr (DV == 128) AT_RDH(vfb, 1, 0); else AT_RDH(vfb, 0, 1);
            __builtin_amdgcn_sched_barrier(0);
            AT_PVH(vfa, 0, 0);
            if constexpr (DV == 128) AT_PVH(vfb, 1, 0);
#pragma unroll
            for (int r = 0; r < 16; ++r) { s1[r] = __builtin_amdgcn_exp2f(s1[r] - msub1); ps += s1[r]; }
#pragma unroll
            for (int i = 0; i < 4; ++i) { pw[2][i] = pk2(s1[2 * i], s1[2 * i + 1]); pw[3][i] = pk2(s1[8 + 2 * i], s1[8 + 2 * i + 1]); }
#pragma unroll
            for (int i = 0; i < (DV == 128 ? 8 : 4); ++i) { __builtin_amdgcn_sched_group_barrier(0x008, 1, 0); __builtin_amdgcn_sched_group_barrier(0x402, (DV == 128 ? 7 : 14), 0); }
            __builtin_amdgcn_sched_barrier(0);
            if constexpr (DV == 128) {
                AT_RDH(vfa, 0, 1); AT_RDH(vfb, 1, 1); __builtin_amdgcn_sched_barrier(0);
                AT_PVH(vfa, 0, 1); AT_PVH(vfb, 1, 1);
            } else {
                AT_PVH(vfb, 0, 1);
            }
            lrun += ps;
            __builtin_amdgcn_sched_barrier(0);
#undef AT_PVH
#undef AT_RDH
#undef AT_RDV
        }
        }
        --t; ++it;
        { LAS unsigned char* buf = bufB;
        if (t <= tmax_w && !done) {
            const float bmax = FOX ? ((const LAS float*)(buf + AT_B))[63] : slope_l2 * (float)(64 * t + 63 - q0);
            if (__all(ubase + bmax < mrun)) done = true;
        }
        if (t <= tmax_w && !done) {
            const float base_t = FOX ? 0.f : slope_l2 * (float)(64 * t - q0); float c32 = 0.f, hadd = 0.f;
            f32x16 s0, s1;
#pragma unroll
            for (int r = 0; r < 16; ++r) { s0[r] = 0.f; s1[r] = 0.f; }
            const LAS unsigned char* kb = buf + AT_K + r32 * KP + hi * 16;
            const LAS unsigned char* vb = buf + AT_V + (4 * hi + ((lane & 15) >> 2)) * VP + (16 * ((lane >> 4) & 1) + 4 * (lane & 3)) * 2;
            bf16x8 kf[8];
#pragma unroll
            for (int d0 = 0; d0 < 4; ++d0) { kf[2 * d0] = *(const LAS bf16x8*)(kb + d0 * 32); kf[2 * d0 + 1] = *(const LAS bf16x8*)(kb + 32 * KP + d0 * 32); }
            __builtin_amdgcn_sched_barrier(0);
#pragma unroll
            for (int d0 = 0; d0 < 4; ++d0) {
                s0 = __builtin_amdgcn_mfma_f32_32x32x16_bf16(kf[2 * d0], qf[d0], s0, 0, 0, 0);
                s1 = __builtin_amdgcn_mfma_f32_32x32x16_bf16(kf[2 * d0 + 1], qf[d0], s1, 0, 0, 0);
            }
            s16x4 vfa[8], vfb[8];
#define AT_RDV(dst, db) do { _Pragma("unroll") for (int ks_ = 0; ks_ < 4; ++ks_) { dst[2 * ks_] = vtr(vb + (16 * ks_) * VP + (db) * 64); dst[2 * ks_ + 1] = vtr(vb + (16 * ks_ + 8) * VP + (db) * 64); } } while (0)
            if (FOX) {
                const LAS float* bb = (const LAS float*)(buf + AT_B);
#pragma unroll
                for (int g = 0; g < 4; ++g) { const f32x4 b0 = *(const LAS f32x4*)(bb + 8 * g + 4 * hi), b1 = *(const LAS f32x4*)(bb + 32 + 8 * g + 4 * hi);
#pragma unroll
                    for (int j = 0; j < 4; ++j) { s0[4 * g + j] = s0[4 * g + j] * C2 + b0[j]; s1[4 * g + j] = s1[4 * g + j] * C2 + b1[j]; } }
                if (t == tmax_w) { const int qil = 32 * (w & 1) + r32;
#pragma unroll
                    for (int r = 0; r < 16; ++r) { const int j0 = crow(r, hi); if (j0 > qil) s0[r] = NEGBIG; if (j0 + 32 > qil) s1[r] = NEGBIG; } }
            } else {
                if (t == tmax_w) { const int il = qrow - 64 * t;
#pragma unroll
                    for (int r = 0; r < 16; ++r) { const int j0 = crow(r, hi), j1 = j0 + 32;
                        s0[r] = s0[r] * C2 + slope_l2 * (float)(j0 > il ? 2 * il - j0 : j0); s1[r] = s1[r] * C2 + slope_l2 * (float)(j1 > il ? 2 * il - j1 : j1); }
                } else {
#pragma unroll
                    for (int r = 0; r < 16; ++r) { const float cc = slope_l2 * (float)crow(r, 0); s0[r] = s0[r] * C2 + cc; s1[r] = s1[r] * C2 + cc; }
                    c32 = 32.f * slope_l2; hadd = hterm;
                }
            }
            float mx0 = s0[0], mx1 = s1[0];
#pragma unroll
            for (int r = 1; r < 16; ++r) { mx0 = fmaxf(mx0, s0[r]); mx1 = fmaxf(mx1, s1[r]); }
            float mx = fmaxf(mx0, mx1 + c32) + hadd;
            mx = half_max(mx) + base_t;
            const float mnew = fmaxf(mrun, mx), msub = mnew - base_t - hadd, msub1 = msub - c32;
            if (__any(mnew > mrun)) { const float alpha = __builtin_amdgcn_exp2f(mrun - mnew); lrun *= alpha;
#pragma unroll
                for (int db = 0; db < DV / 32; ++db)
#pragma unroll
                    for (int r = 0; r < 16; ++r) O[db][r] *= alpha; }
            mrun = mnew;
#define AT_RDH(dst, dp, kh) do { _Pragma("unroll") for (int d_ = 0; d_ < 2; ++d_) _Pragma("unroll") for (int k_ = 0; k_ < 2; ++k_) { \
                dst[d_ * 4 + k_ * 2] = vtr(vb + (16 * (2 * (kh) + k_)) * VP + (2 * (dp) + d_) * 64); dst[d_ * 4 + k_ * 2 + 1] = vtr(vb + (16 * (2 * (kh) + k_) + 8) * VP + (2 * (dp) + d_) * 64); } } while (0)
#define AT_PVH(cur, dp, kh) do { _Pragma("unroll") for (int d_ = 0; d_ < 2; ++d_) _Pragma("unroll") for (int k_ = 0; k_ < 2; ++k_) { \
                const s16x4 lo_ = cur[d_ * 4 + k_ * 2], hi_ = cur[d_ * 4 + k_ * 2 + 1]; \
                const bf16x8 vf_ = (bf16x8){lo_[0], lo_[1], lo_[2], lo_[3], hi_[0], hi_[1], hi_[2], hi_[3]}; \
                O[2 * (dp) + d_] = __builtin_amdgcn_mfma_f32_32x32x16_bf16(vf_, __builtin_bit_cast(bf16x8, pw[2 * (kh) + k_]), O[2 * (dp) + d_], 0, 0, 0); } } while (0)
            __builtin_amdgcn_sched_barrier(0);
            AT_RDH(vfa, 0, 0);
            __builtin_amdgcn_sched_barrier(0);
            float ps = 0.f; u32x4 pw[4];
#pragma unroll
            for (int r = 0; r < 16; ++r) { s0[r] = __builtin_amdgcn_exp2f(s0[r] - msub); ps += s0[r]; }
#pragma unroll
            for (int i = 0; i < 4; ++i) { pw[0][i] = pk2(s0[2 * i], s0[2 * i + 1]); pw[1][i] = pk2(s0[8 + 2 * i], s0[8 + 2 * i + 1]); }
            __builtin_amdgcn_sched_barrier(0);
            if constexpr (DV == 128) AT_RDH(vfb, 1, 0); else AT_RDH(vfb, 0, 1);
            __builtin_amdgcn_sched_barrier(0);
            AT_PVH(vfa, 0, 0);
            if constexpr (DV == 128) AT_PVH(vfb, 1, 0);
#pragma unroll
            for (int r = 0; r < 16; ++r) { s1[r] = __builtin_amdgcn_exp2f(s1[r] - msub1); ps += s1[r]; }
#pragma unroll
            for (int i = 0; i < 4; ++i) { pw[2][i] = pk2(s1[2 * i], s1[2 * i + 1]); pw[3][i] = pk2(s1[8 + 2 * i], s1[8 + 2 * i + 1]); }
#pragma unroll
            for (int i = 0; i < (DV == 128 ? 8 : 4); ++i) { __builtin_amdgcn_sched_group_barrier(0x008, 1, 0); __builtin_amdgcn_sched_group_barrier(0x402, (DV == 128 ? 7 : 14), 0); }
            __builtin_amdgcn_sched_barrier(0);
            if constexpr (DV == 128) {
                AT_RDH(vfa, 0, 1); AT_RDH(vfb, 1, 1); __builtin_amdgcn_sched_barrier(0);
                AT_PVH(vfa, 0, 1); AT_PVH(vfb, 1, 1);
            } else {
                AT_PVH(vfb, 0, 1);
            }
            lrun += ps;
            __builtin_amdgcn_sched_barrier(0);
#undef AT_PVH
#undef AT_RDH
#undef AT_RDV
        }
        }
        if (lane == 0) flags[(pr & 1) * 8 + w] = done ? 1 : 0;
      }
      --t; ++it; if (t < 0) break;
    }
#undef AT_ISSUE
    __syncthreads();
    l_out = half_sum(lrun);
}

DI void fox_unit(const Args& a, LAS unsigned char* lds, int l, int b, int h, int qb) {
    const int tid = lt_tid(), lane = tid & 63, w = tid >> 6, r32 = lane & 31, hi = lane >> 5;
    const bf16_t* P = (const bf16_t*)(WSP(a) + WS_UP); bf16_t* CAT = (bf16_t*)(WSP(a) + WS_H);
    const size_t rowbase = (size_t)b * SEQ; const int q0 = qb * 256;
    f32x16 O[2]; float lt;
    const float sb = C2 * sqrtf(((const float*)(WSP(a) + WS_LAM))[80 + (l * 2 + b) * 12 + h]);
    attn_pass<64, true, 0>(lds, P, rowbase, q0, PC_QA + h * 64, PC_KA + h * 64, PC_VA + h * 64, (const float*)(WSP(a) + WS_CLOC), (const float*)(WSP(a) + WS_CTOT) + b * 64 * 4, h, sb, O, lt);
    const float inv = 1.f / lt;
    bf16_t* op = CAT + (rowbase + q0 + 32 * w + r32) * DM + h * 64;
#pragma unroll
    for (int db = 0; db < 2; ++db)
#pragma unroll
        for (int g = 0; g < 4; ++g) { u32x2 wv; wv.x = pk2(O[db][4 * g] * inv, O[db][4 * g + 1] * inv); wv.y = pk2(O[db][4 * g + 2] * inv, O[db][4 * g + 3] * inv);
            *(u32x2*)(op + db * 32 + 8 * g + 4 * hi) = wv; }
}
typedef _Float16 h16x4 __attribute__((ext_vector_type(4)));
DI void diff_pass_unit(const Args& a, LAS unsigned char* lds, int l, int b, int h, int qb, int pass) {
    const bf16_t* P = (const bf16_t*)(WSP(a) + WS_UP);
    const size_t rowbase = (size_t)b * SEQ; const int q0 = qb * 256;
    const float sb = C2 * sqrtf(((const float*)(WSP(a) + WS_LAM))[80 + (l * 2 + b) * 12 + 4 + h * 2 + pass]);
    f32x16 O[4]; float lt;
    const int qc = PC_QC + h * 128 + pass * 64, kc = PC_KC + h * 128 + pass * 64, vc = PC_VC + h * 128;
    if (h == 0) attn_pass<128, false, 0>(lds, P, rowbase, q0, qc, kc, vc, nullptr, nullptr, h, sb, O, lt);
    else if (h == 1) attn_pass<128, false, 1>(lds, P, rowbase, q0, qc, kc, vc, nullptr, nullptr, h, sb, O, lt);
    else if (h == 2) attn_pass<128, false, 2>(lds, P, rowbase, q0, qc, kc, vc, nullptr, nullptr, h, sb, O, lt);
    else attn_pass<128, false, 3>(lds, P, rowbase, q0, qc, kc, vc, nullptr, nullptr, h, sb, O, lt);
    const int tid = lt_tid(), lane = tid & 63, w = tid >> 6, r32 = lane & 31, hi = lane >> 5;
    const float inv = 1.f / lt;
    _Float16* op = (_Float16*)(WSP(a) + WS_OSCR) + ((size_t)pass * NTP + rowbase + q0 + 32 * w + r32) * 512 + h * 128;
#pragma unroll
    for (int db = 0; db < 4; ++db)
#pragma unroll
        for (int g = 0; g < 4; ++g) { h16x4 v; v[0] = (_Float16)(O[db][4 * g] * inv); v[1] = (_Float16)(O[db][4 * g + 1] * inv); v[2] = (_Float16)(O[db][4 * g + 2] * inv); v[3] = (_Float16)(O[db][4 * g + 3] * inv);
            *(h16x4*)(op + db * 32 + 8 * g + 4 * hi) = v; }
}
DI void phase_diff_combine(const Args& a, int l) {
    const int tid = lt_tid(), lane = tid & 63, wave = tid >> 6;
    const float lam = ((const float*)(WSP(a) + WS_LAM))[l]; const float omli = one_minus_lam_init(l);
    const _Float16* OS = (const _Float16*)(WSP(a) + WS_OSCR); bf16_t* CAT = (bf16_t*)(WSP(a) + WS_H);
    const float* gd = AIN(a, I_GDIFF) + l * 128 + (lane & 15) * 8;
    const f32x4 g0 = *(const f32x4*)gd, g1 = *(const f32x4*)(gd + 4);
    for (int m = blockIdx.x * 8 + wave; m < NTP; m += gridDim.x * 8) {
        const h16x4* p0 = (const h16x4*)(OS + (size_t)m * 512 + lane * 8); const h16x4* p1 = (const h16x4*)(OS + ((size_t)NTP + m) * 512 + lane * 8);
        const h16x4 a0 = p0[0], a1 = p0[1], b0 = p1[0], b1 = p1[1];
        float o[8]; float ss = 0.f;
#pragma unroll
        for (int j = 0; j < 4; ++j) { o[j] = (float)a0[j] - lam * (float)b0[j]; o[4 + j] = (float)a1[j] - lam * (float)b1[j]; }
#pragma unroll
        for (int j = 0; j < 8; ++j) ss += o[j] * o[j];
#pragma unroll
        for (int x = 1; x < 16; x <<= 1) ss += __shfl_xor(ss, x);
        const float rr = rsqrtf(ss * (1.f / 128.f) + EPS) * omli;
        u32x4 wv; wv.x = pk2(o[0] * rr * g0[0], o[1] * rr * g0[1]); wv.y = pk2(o[2] * rr * g0[2], o[3] * rr * g0[3]); wv.z = pk2(o[4] * rr * g1[0], o[5] * rr * g1[1]); wv.w = pk2(o[6] * rr * g1[2], o[7] * rr * g1[3]);
        *(u32x4*)(CAT + (size_t)m * DM + 512 + lane * 8) = wv;
    }
}
DI void kn_item(const Args& a, int l, int tile, int lane) {
    const bf16_t* P = (const bf16_t*)(WSP(a) + WS_UP); unsigned* KN = (unsigned*)(WSP(a) + WS_LAM) + 80 + (l * 2 + (tile >> 8)) * 12;
    const bf16_t* rp = P + (size_t)(tile * 64 + lane) * NPROJ;
#pragma unroll 4
    for (int hm = 0; hm < 12; ++hm) { const bf16_t* kp = rp + (hm < 4 ? PC_KA + hm * 64 : PC_KC + (hm - 4) * 64); float ss = 0.f;
#pragma unroll
        for (int i = 0; i < 8; ++i) { const u32x4 r = *(const u32x4*)(kp + 8 * i);
#pragma unroll
            for (int j = 0; j < 4; ++j) { const float x = __uint_as_float(r[j] << 16), y = __uint_as_float(r[j] & 0xffff0000u); ss += x * x + y * y; } }
        ss = wave_max(ss); if (lane == 0) atomicMax(KN + hm, __float_as_uint(ss)); }
}

DI void gla_local_item(const Args& a, LAS unsigned char* lds, int l, int b, int n) {
    lds = lnd(lds);
    const int tid = lt_tid();
    const bf16_t* P = (const bf16_t*)(WSP(a) + WS_UP); const float* PF = (const float*)(WSP(a) + WS_PF);
    LAS float* gb = (LAS float*)lds;
    LAS float* cb = gb + 64 * 16;
    LAS float* kl = cb + 64 * 128;
    LAS float* vv = kl + 64 * 128;
    const size_t m0 = (size_t)b * SEQ + 64 * n;
    { const int t = tid >> 3, c = (tid & 7) * 2; const float* p = PF + (m0 + t) * 32 + 4 + c; gb[t * 16 + c] = p[0]; gb[t * 16 + c + 1] = p[1]; }
#pragma unroll
    for (int i = 0; i < 2; ++i) { const int ch = tid + 512 * i, t = ch >> 4, c = (ch & 15) * 8; const u32x4 r = *(const u32x4*)(P + (m0 + t) * NPROJ + PC_KB + c);
#pragma unroll
        for (int j = 0; j < 4; ++j) { kl[t * 128 + c + 2 * j] = __uint_as_float(r[j] << 16); kl[t * 128 + c + 2 * j + 1] = __uint_as_float(r[j] & 0xffff0000u); } }
#pragma unroll
    for (int i = 0; i < 4; ++i) { const int ch = tid + 512 * i, t = ch >> 5, c = (ch & 31) * 8; const u32x4 r = *(const u32x4*)(P + (m0 + t) * NPROJ + PC_VB + c);
#pragma unroll
        for (int j = 0; j < 4; ++j) { vv[t * 256 + c + 2 * j] = __uint_as_float(r[j] << 16); vv[t * 256 + c + 2 * j + 1] = __uint_as_float(r[j] & 0xffff0000u); } }
    __syncthreads();
    { const int col = tid & 127, tq = tid >> 7; float W[16];
#pragma unroll
      for (int r = 0; r < 16; ++r) W[r] = AIN(a, I_WGU)[(l * 16 + r) * 128 + col];
      const float bu = AIN(a, I_BGU)[l * 128 + col];
      for (int t = tq * 16; t < tq * 16 + 16; ++t) { float z = bu;
#pragma unroll
          for (int r4 = 0; r4 < 4; ++r4) { const f32x4 gq = *(const LAS f32x4*)(gb + t * 16 + 4 * r4); z += (gq.x * W[4 * r4] + gq.y * W[4 * r4 + 1]) + (gq.z * W[4 * r4 + 2] + gq.w * W[4 * r4 + 3]); }
          cb[t * 128 + col] = logsig(z) * (1.f / 16.f); } }
    __syncthreads();
    { const int col = tid & 127, q = tid >> 7; float v[16]; float run = 0.f;
#pragma unroll
      for (int i = 0; i < 16; ++i) { run += cb[(q * 16 + i) * 128 + col]; v[i] = run; }
      gb[q * 128 + col] = run;
      __syncthreads();
      float off = 0.f;
#pragma unroll
      for (int qq = 0; qq < 3; ++qq) if (qq < q) off += gb[qq * 128 + col];
#pragma unroll
      for (int i = 0; i < 16; ++i) cb[(q * 16 + i) * 128 + col] = v[i] + off; }
    __syncthreads();
    { float* CB = (float*)(WSP(a) + WS_CB) + m0 * 128;
#pragma unroll
      for (int i = 0; i < 16; ++i) { const int e = tid + 512 * i, c = e & 127; const float cv = cb[e]; CB[e] = cv; kl[e] *= __expf(cb[63 * 128 + c] - cv); }
      if (tid < 128) ((float*)(WSP(a) + WS_GDEC))[((size_t)(b * 256 + n) * 4) * 32 + tid] = __expf(cb[63 * 128 + tid]); }
    __syncthreads();
    { const int h = tid >> 7, kh = (tid >> 6) & 1, v = tid & 63; float acc[16];
#pragma unroll
      for (int k = 0; k < 16; ++k) acc[k] = 0.f;
#pragma unroll 4
      for (int t = 0; t < 64; ++t) { const float vx = vv[t * 256 + h * 64 + v]; const LAS f32x4* kr = (const LAS f32x4*)(kl + t * 128 + h * 32 + kh * 16);
#pragma unroll
          for (int k4 = 0; k4 < 4; ++k4) { const f32x4 kq = kr[k4]; acc[4 * k4] += kq.x * vx; acc[4 * k4 + 1] += kq.y * vx; acc[4 * k4 + 2] += kq.z * vx; acc[4 * k4 + 3] += kq.w * vx; } }
      float* U = (float*)(WSP(a) + WS_GU) + ((size_t)((b * 256 + n) * 4 + h) * 32 + kh * 16) * 64 + v;
#pragma unroll
      for (int k = 0; k < 16; ++k) U[k * 64] = acc[k]; }
    __syncthreads();
}
DI void gla_scan_item(const Args& a, int l, int item) {
    const int tid = lt_tid(), b = item >> 4, h = (item >> 2) & 3, e = (item & 3) * 512 + tid, k = e >> 6;
    const float* U = (const float*)(WSP(a) + WS_GU); const float* DEC = (const float*)(WSP(a) + WS_GDEC); float* GS = (float*)(WSP(a) + WS_GS);
    float S = 0.f;
#pragma unroll 32
    for (int n = 0; n < 256; ++n) { const size_t ch = (size_t)(b * 256 + n) * 4 + h; GS[ch * 2048 + e] = S; S = DEC[ch * 32 + k] * S + U[ch * 2048 + e]; }
    OUTP(a)[O_GSP + (size_t)((l * 2 + b) * 4 + h) * 2048 + e] = S;
}
DI void gla_out_item(const Args& a, LAS unsigned char* lds, int l, int b, int n, int h) {
    lds = lnd(lds);
    const int tid = lt_tid(), lane = tid & 63, wv = tid >> 6;
    const bf16_t* P = (const bf16_t*)(WSP(a) + WS_UP); bf16_t* CAT = (bf16_t*)(WSP(a) + WS_H);
    LAS float* qe = (LAS float*)lds;
    LAS float* ke = qe + 64 * 36;
    LAS float* vv = ke + 64 * 36;
    LAS float* Ss = vv + 64 * 64;
    LAS float* A = Ss + 32 * 64;
    LAS float* rb = A + 64 * 68;
    const size_t m0 = (size_t)b * SEQ + 64 * n;
    { const int half = tid >> 8, c = tid & 255, t = c >> 2, k0 = (c & 3) * 8;
      const u32x4 r = *(const u32x4*)(P + (m0 + t) * NPROJ + (half ? PC_KB : PC_QB) + h * 32 + k0);
      const float* cp = (const float*)(WSP(a) + WS_CB) + (m0 + t) * 128 + h * 32 + k0; const f32x4 c0 = *(const f32x4*)cp, c1 = *(const f32x4*)(cp + 4);
      LAS float* dst = (half ? ke : qe) + t * 36 + k0;
#pragma unroll
      for (int j = 0; j < 4; ++j) { const float x0 = __uint_as_float(r[j] << 16), x1 = __uint_as_float(r[j] & 0xffff0000u); const float ca = (j < 2 ? c0[2 * j] : c1[2 * j - 4]), cb1 = (j < 2 ? c0[2 * j + 1] : c1[2 * j - 3]);
          dst[2 * j] = half ? x0 * __expf(-ca) : x0 * 0.17677669529663687f * __expf(ca); dst[2 * j + 1] = half ? x1 * __expf(-cb1) : x1 * 0.17677669529663687f * __expf(cb1); } }
    { const int t = tid >> 3, c = (tid & 7) * 8; const u32x4 r = *(const u32x4*)(P + (m0 + t) * NPROJ + PC_VB + h * 64 + c), r2 = *(const u32x4*)(P + (m0 + t) * NPROJ + PC_RB + h * 64 + c);
#pragma unroll
      for (int j = 0; j < 4; ++j) { vv[t * 64 + c + 2 * j] = __uint_as_float(r[j] << 16); vv[t * 64 + c + 2 * j + 1] = __uint_as_float(r[j] & 0xffff0000u);
          rb[t * 64 + c + 2 * j] = silu_f(__uint_as_float(r2[j] << 16)); rb[t * 64 + c + 2 * j + 1] = silu_f(__uint_as_float(r2[j] & 0xffff0000u)); } }
    { const float* GS = (const float*)(WSP(a) + WS_GS) + ((size_t)(b * 256 + n) * 4 + h) * 2048; *(LAS f32x4*)(Ss + tid * 4) = *(const f32x4*)(GS + tid * 4); }
    __syncthreads();
    { float acc[8];
#pragma unroll
      for (int i = 0; i < 8; ++i) acc[i] = 0.f;
#pragma unroll
      for (int k4 = 0; k4 < 8; ++k4) { const f32x4 kv = *(const LAS f32x4*)(ke + lane * 36 + 4 * k4);
#pragma unroll
          for (int i = 0; i < 8; ++i) { const f32x4 qv = *(const LAS f32x4*)(qe + (wv + 8 * i) * 36 + 4 * k4); acc[i] += (qv.x * kv.x + qv.y * kv.y) + (qv.z * kv.z + qv.w * kv.w); } }
#pragma unroll
      for (int i = 0; i < 8; ++i) A[(wv + 8 * i) * 68 + lane] = (lane <= wv + 8 * i) ? acc[i] : 0.f; }
    __syncthreads();
    float o[8];
#pragma unroll
    for (int i = 0; i < 8; ++i) o[i] = 0.f;
#pragma unroll 4
    for (int m4 = 0; m4 < 16; ++m4) { const float v0 = vv[(4 * m4) * 64 + lane], v1 = vv[(4 * m4 + 1) * 64 + lane], v2 = vv[(4 * m4 + 2) * 64 + lane], v3 = vv[(4 * m4 + 3) * 64 + lane];
#pragma unroll
        for (int i = 0; i < 8; ++i) { const f32x4 av = *(const LAS f32x4*)(A + (wv + 8 * i) * 68 + 4 * m4); o[i] += (av.x * v0 + av.y * v1) + (av.z * v2 + av.w * v3); } }
#pragma unroll 4
    for (int k4 = 0; k4 < 8; ++k4) { const float s0 = Ss[(4 * k4) * 64 + lane], s1 = Ss[(4 * k4 + 1) * 64 + lane], s2 = Ss[(4 * k4 + 2) * 64 + lane], s3 = Ss[(4 * k4 + 3) * 64 + lane];
#pragma unroll
        for (int i = 0; i < 8; ++i) { const f32x4 qv = *(const LAS f32x4*)(qe + (wv + 8 * i) * 36 + 4 * k4); o[i] += (qv.x * s0 + qv.y * s1) + (qv.z * s2 + qv.w * s3); } }
    const float gg = AIN(a, I_GGLA)[l * 64 + lane];
#pragma unroll
    for (int i = 0; i < 8; ++i) { const int t = wv + 8 * i; const float rr = rsqrtf(wave_sum(o[i] * o[i]) * (1.f / 64.f) + EPS);
        CAT[(m0 + t) * DM + 256 + h * 64 + lane] = (bf16_t)(pk2(o[i] * rr * gg * rb[t * 64 + lane], 0.f) & 0xffffu); }
    __syncthreads();
}

DI void logf_item(const Args& a, int l, int tile, int h, int lane) {
    const float* PF = (const float*)(WSP(a) + WS_PF); const float bf = AIN(a, I_BF)[l * 4 + h];
    const int m0 = tile * 256 + 4 * lane; float lf[4];
#pragma unroll
    for (int i = 0; i < 4; ++i) lf[i] = logsig(PF[(size_t)(m0 + i) * 32 + h] + bf);
    if (tile == 128) {
#pragma unroll
        for (int i = 0; i < 4; ++i) OUTP(a)[O_FLS + ((size_t)l * NTS + (m0 + i - NTP)) * 4 + h] = lf[i];
        return; }
#pragma unroll
    for (int i = 0; i < 4; ++i) OUTP(a)[O_FLP + ((size_t)l * NTP + m0 + i) * 4 + h] = lf[i];
    lf[1] += lf[0]; lf[2] += lf[1]; lf[3] += lf[2];
    float inc = lf[3];
#pragma unroll
    for (int o = 1; o < 64; o <<= 1) { const float v = __shfl_up(inc, o); if (lane >= o) inc += v; }
    const float excl = inc - lf[3];
    float* CL = (float*)(WSP(a) + WS_CLOC);
#pragma unroll
    for (int i = 0; i < 4; ++i) CL[(size_t)(m0 + i) * 4 + h] = excl + lf[i];
    if (lane == 63) ((float*)(WSP(a) + WS_CTOT))[tile * 4 + h] = inc;
}

#define MINI_IN_GEMM 1
constexpr int NKS = 1040;
DI void samp_softmax(LAS float* S, LAS float* linv, int tid) {
    const int lane = tid & 63, wv = tid >> 6;
#pragma unroll
    for (int rr = 0; rr < 2; ++rr) { LAS float* row = S + (2 * wv + rr) * NKS; float mx = NEGBIG;
        for (int j = lane; j < NKS; j += 64) mx = fmaxf(mx, row[j]);
        mx = wave_max(mx); float sm = 0.f;
        for (int j = lane; j < NKS; j += 64) { const float p = __expf(row[j] - mx); row[j] = p; sm += p; }
        sm = wave_sum(sm); if (lane == 0) linv[2 * wv + rr] = 1.f / sm; }
}
template <bool FOX>
DI void samp_scores(LAS float* S, const LAS float* qs, const LAS float* caux, const float* kc, const float* kn, int KW, float slope, int tid) {
    const float cref = FOX ? caux[NKS - 1] : 0.f;
    for (int j = tid; j < NKS; j += 512) {
        const float* kr = j < 1024 ? kc + (size_t)j * KW : kn + (size_t)(j - 1024) * KW;
        f32x4 kv[16];
#pragma unroll
        for (int i = 0; i < 16; ++i) kv[i] = *(const f32x4*)(kr + 4 * i);
        const float bj = FOX ? cref - caux[j] : 0.f;
#pragma unroll 4
        for (int qi = 0; qi < 16; ++qi) { float d = 0.f;
#pragma unroll
            for (int i = 0; i < 16; ++i) { const f32x4 q = *(const LAS f32x4*)(qs + qi * 64 + 4 * i); d += (q.x * kv[i].x + q.y * kv[i].y) + (q.z * kv[i].z + q.w * kv[i].w); }
            float s = d * 0.125f;
            if (FOX) { s += bj; if (j > 1024 + qi) s = NEGBIG; } else s -= slope * fabsf((float)(1024 + qi - j));
            S[qi * NKS + j] = s; }
    }
}
DI void fox_sample_item(const Args& a, LAS unsigned char* lds, int l, int b, int h) {
    lds = lnd(lds);
    const int tid = lt_tid(), lane = tid & 63;
    const bf16_t* P = (const bf16_t*)(WSP(a) + WS_UP); bf16_t* CAT = (bf16_t*)(WSP(a) + WS_H);
    LAS float* S = (LAS float*)lds; LAS float* qs = S + 16 * NKS; LAS float* caux = qs + 16 * 64; LAS float* linv = caux + NKS + 8;
    const int m0 = NTP + b * 16; const size_t lb = (size_t)l * 16 + b;
    for (int e = tid; e < 1024; e += 512) qs[e] = bf2f(P[(size_t)(m0 + (e >> 6)) * NPROJ + PC_QA + h * 64 + (e & 63)]);
    if (tid < 64) { const float* cl = AIN(a, I_CFL) + (lb * 1024 + 16 * lane) * 4 + h; float v[16]; float run = 0.f;
#pragma unroll
        for (int i = 0; i < 16; ++i) { run += cl[i * 4]; v[i] = run; }
        float inc = run;
#pragma unroll
        for (int o = 1; o < 64; o <<= 1) { const float t = __shfl_up(inc, o); if (lane >= o) inc += t; }
        const float ex = inc - run;
#pragma unroll
        for (int i = 0; i < 16; ++i) caux[16 * lane + i] = ex + v[i]; }
    __syncthreads();
    if (tid == 0) { float run = caux[1023]; for (int t = 0; t < 16; ++t) { run += OUTP(a)[O_FLS + (lb * 16 + t) * 4 + h]; caux[1024 + t] = run; } }
    __syncthreads();
    samp_scores<true>(S, qs, caux, AIN(a, I_CFK) + (lb * 1024 * 4 + h) * 64, OUTP(a) + O_FKS + (lb * 16 * 4 + h) * 64, 256, 0.f, tid);
    __syncthreads();
    samp_softmax(S, linv, tid);
    __syncthreads();
    {
      const int wv = tid >> 6; LAS float* red = (LAS float*)(lds + 80000);
      const float* vc = AIN(a, I_CFV) + (lb * 1024 * 4 + h) * 64 + lane; const float* vn = OUTP(a) + O_FVS + (lb * 16 * 4 + h) * 64 + lane;
      float acc[16];
#pragma unroll
      for (int i = 0; i < 16; ++i) acc[i] = 0.f;
#pragma unroll 5
      for (int jj = 0; jj < 130; ++jj) { const int j = 130 * wv + jj; const float v = j < 1024 ? vc[(size_t)j * 256] : vn[(size_t)(j - 1024) * 256];
#pragma unroll
          for (int i = 0; i < 16; ++i) acc[i] += S[i * NKS + j] * v; }
#pragma unroll
      for (int i = 0; i < 16; ++i) red[(wv * 16 + i) * 64 + lane] = acc[i];
      __syncthreads();
      const int d = tid & 63, qg = tid >> 6;
#pragma unroll
      for (int r = 0; r < 2; ++r) { const int qi = 2 * qg + r; float sum = 0.f;
#pragma unroll
          for (int x = 0; x < 8; ++x) sum += red[(x * 16 + qi) * 64 + d];
          CAT[(size_t)(m0 + qi) * DM + h * 64 + d] = (bf16_t)(pk2(sum * linv[qi], 0.f) & 0xffffu); } }
    __syncthreads();
}
DI void diff_sample_item(const Args& a, LAS unsigned char* lds, int l, int b, int h) {
    lds = lnd(lds);
    const int tid = lt_tid(), lane = tid & 63, wv = tid >> 6;
    const bf16_t* P = (const bf16_t*)(WSP(a) + WS_UP); bf16_t* CAT = (bf16_t*)(WSP(a) + WS_H);
    LAS float* S = (LAS float*)lds; LAS float* qs = S + 16 * NKS; LAS float* caux = qs + 16 * 64; LAS float* linv = caux + NKS + 8; LAS float* red = linv + 16;
    const int m0 = NTP + b * 16; const size_t lb = (size_t)l * 16 + b;
    const float slope = exp2f(-2.f * (float)(h + 1)), lam = ((const float*)(WSP(a) + WS_LAM))[l]; const float omli = one_minus_lam_init(l);
    const int d = tid & 127, qg = tid >> 7;
    float o[4] = {0.f, 0.f, 0.f, 0.f};
    for (int mp = 0; mp < 2; ++mp) {
        for (int e = tid; e < 1024; e += 512) qs[e] = bf2f(P[(size_t)(m0 + (e >> 6)) * NPROJ + PC_QC + h * 128 + mp * 64 + (e & 63)]);
        __syncthreads();
        samp_scores<false>(S, qs, caux, AIN(a, I_CDK) + (lb * 1024 * 4 + h) * 128 + mp * 64, OUTP(a) + O_DKS + (lb * 16 * 4 + h) * 128 + mp * 64, 512, slope, tid);
        __syncthreads();
        samp_softmax(S, linv, tid);
        __syncthreads();
        { LAS float* redv = (LAS float*)(lds + 80000);
          const float* vc = AIN(a, I_CDV) + (lb * 1024 * 4 + h) * 128 + lane; const float* vn = OUTP(a) + O_DVS + (lb * 16 * 4 + h) * 128 + lane;
          float acc0[16], acc1[16];
#pragma unroll
          for (int i = 0; i < 16; ++i) { acc0[i] = 0.f; acc1[i] = 0.f; }
#pragma unroll 5
          for (int jj = 0; jj < 130; ++jj) { const int j = 130 * wv + jj; const float* vp = j < 1024 ? vc + (size_t)j * 512 : vn + (size_t)(j - 1024) * 512; const float v0 = vp[0], v1 = vp[64];
#pragma unroll
              for (int i = 0; i < 16; ++i) { const float p = S[i * NKS + j]; acc0[i] += p * v0; acc1[i] += p * v1; } }
#pragma unroll
          for (int i = 0; i < 16; ++i) { redv[(wv * 16 + i) * 128 + lane] = acc0[i]; redv[(wv * 16 + i) * 128 + 64 + lane] = acc1[i]; }
          __syncthreads();
#pragma unroll
          for (int i = 0; i < 4; ++i) { float sum = 0.f;
#pragma unroll
              for (int x = 0; x < 8; ++x) sum += redv[(x * 16 + 4 * qg + i) * 128 + d];
              const float v = sum * linv[4 * qg + i]; o[i] = (mp == 0) ? v : o[i] - lam * v; } }
        __syncthreads();
    }
#pragma unroll
    for (int i = 0; i < 4; ++i) { const float s = wave_sum(o[i] * o[i]); if (lane == 0) red[wv * 4 + i] = s; }
    __syncthreads();
    const float gd = AIN(a, I_GDIFF)[l * 128 + d] * omli;
#pragma unroll
    for (int i = 0; i < 4; ++i) { const float tot = red[(2 * qg) * 4 + i] + red[(2 * qg + 1) * 4 + i]; const float rr = rsqrtf(tot * (1.f / 128.f) + EPS);
        CAT[(size_t)(m0 + 4 * qg + i) * DM + 512 + h * 128 + d] = (bf16_t)(pk2(o[i] * rr * gd, 0.f) & 0xffffu); }
    __syncthreads();
}
DI void gla_sample_item(const Args& a, int l, int b, int h, int lane) {
    const bf16_t* P = (const bf16_t*)(WSP(a) + WS_UP); bf16_t* CAT = (bf16_t*)(WSP(a) + WS_H); const float* PF = (const float*)(WSP(a) + WS_PF);
    const size_t sb = (((size_t)l * 16 + b) * 4 + h) * 2048;
    float S[32];
#pragma unroll
    for (int k = 0; k < 32; ++k) S[k] = AIN(a, I_SG)[sb + k * 64 + lane];
    const int kk = lane & 31; float W[16];
#pragma unroll
    for (int r = 0; r < 16; ++r) W[r] = AIN(a, I_WGU)[(l * 16 + r) * 128 + h * 32 + kk];
    const float bu = AIN(a, I_BGU)[l * 128 + h * 32 + kk], gg = AIN(a, I_GGLA)[l * 64 + lane];
    for (int t = 0; t < 16; ++t) { const size_t m = NTP + b * 16 + t;
        float z = bu;
#pragma unroll
        for (int r = 0; r < 16; ++r) z += PF[m * 32 + 4 + r] * W[r];
        const float av = __expf(logsig(z) * (1.f / 16.f));
        const float qv = bf2f(P[m * NPROJ + PC_QB + h * 32 + kk]) * 0.17677669529663687f, kv = bf2f(P[m * NPROJ + PC_KB + h * 32 + kk]);
        const float vx = bf2f(P[m * NPROJ + PC_VB + h * 64 + lane]);
        float o = 0.f;
#pragma unroll
        for (int k = 0; k < 32; ++k) { const float ak = __shfl(av, k), kx = __shfl(kv, k), qx = __shfl(qv, k); S[k] = ak * S[k] + kx * vx; o += qx * S[k]; }
        const float rr = rsqrtf(wave_sum(o * o) * (1.f / 64.f) + EPS);
        const float rb = bf2f(P[m * NPROJ + PC_RB + h * 64 + lane]);
        CAT[m * DM + 256 + h * 64 + lane] = (bf16_t)(pk2(o * rr * gg * silu_f(rb), 0.f) & 0xffffu); }
#pragma unroll
    for (int k = 0; k < 32; ++k) OUTP(a)[O_GSS + sb + k * 64 + lane] = S[k];
}


DI void mini_tile(const bf16_t* __restrict__ A, int lda, const bf16_t* __restrict__ Bt, int ldb, int row0, int brow0, int k0, int ksteps, f32x16& acc, int r32, int hi) {
    const bf16_t* ap = A + (size_t)(row0 + r32) * lda + k0 + 8 * hi; const bf16_t* bp = Bt + (size_t)(brow0 + r32) * ldb + k0 + 8 * hi;
#pragma unroll 8
    for (int s = 0; s < ksteps; ++s) { const bf16x8 av = *(const bf16x8*)(ap + 16 * s), bv = *(const bf16x8*)(bp + 16 * s); acc = __builtin_amdgcn_mfma_f32_32x32x16_bf16(bv, av, acc, 0, 0, 0); }
}
DI void mini_swiglu(const Args& a, int l, int i) {
    const int tid = lt_tid(), lane = tid & 63, wave = tid >> 6, r32 = lane & 31, hi = lane >> 5;
    const bf16_t* H = (const bf16_t*)(WSP(a) + WS_H); const bf16_t* W = (const bf16_t*)(WSP(a) + WS_WFI + (size_t)(l * 2 + i) * SZ_WFI1); bf16_t* U = (bf16_t*)(WSP(a) + WS_UP);
    for (int it = blockIdx.x * 8 + wave; it < 8 * 88; it += gridDim.x * 8) { const int mt = it / 88, g = it % 88, brow = 256 * (g >> 2) + 32 * (g & 3);
        f32x16 ag, au;
#pragma unroll
        for (int r = 0; r < 16; ++r) { ag[r] = 0.f; au[r] = 0.f; }
        const bf16_t* ap = H + (size_t)(NTP + 32 * mt + r32) * DM + 8 * hi; const bf16_t* bg = W + (size_t)(brow + r32) * DM + 8 * hi; const bf16_t* bu = bg + (size_t)128 * DM;
#pragma unroll 4
        for (int s = 0; s < 64; ++s) { const bf16x8 av = *(const bf16x8*)(ap + 16 * s), g8 = *(const bf16x8*)(bg + 16 * s), u8 = *(const bf16x8*)(bu + 16 * s);
            ag = __builtin_amdgcn_mfma_f32_32x32x16_bf16(g8, av, ag, 0, 0, 0); au = __builtin_amdgcn_mfma_f32_32x32x16_bf16(u8, av, au, 0, 0, 0); }
        bf16_t* up = U + (size_t)(NTP + 32 * mt + r32) * DFF + 32 * g + 4 * hi;
#pragma unroll
        for (int q = 0; q < 4; ++q) { u32x2 w; w.x = pk2(silu_f(ag[4 * q]) * au[4 * q], silu_f(ag[4 * q + 1]) * au[4 * q + 1]); w.y = pk2(silu_f(ag[4 * q + 2]) * au[4 * q + 2], silu_f(ag[4 * q + 3]) * au[4 * q + 3]); *(u32x2*)(up + 8 * q) = w; }
    }
}
DI void mini_f32(const Args& a, const bf16_t* A, int lda, const bf16_t* Bt, int K) {
    const int tid = lt_tid(), lane = tid & 63, wave = tid >> 6, r32 = lane & 31, hi = lane >> 5;
    float* YS = (float*)(WSP(a) + WS_YS); const int kc = K / 8;
    for (int it = blockIdx.x * 8 + wave; it < 2048; it += gridDim.x * 8) { const int ks = it & 7, nt = (it >> 3) & 31, mt = it >> 8;
        f32x16 acc;
#pragma unroll
        for (int r = 0; r < 16; ++r) acc[r] = 0.f;
        mini_tile(A, lda, Bt, K, NTP + 32 * mt, 32 * nt, ks * kc, kc / 16, acc, r32, hi);
        float* yp = YS + ((size_t)ks * NTS + 32 * mt + r32) * DM + 32 * nt + 4 * hi;
#pragma unroll
        for (int q = 0; q < 4; ++q) *(f32x4*)(yp + 8 * q) = (f32x4){acc[4 * q], acc[4 * q + 1], acc[4 * q + 2], acc[4 * q + 3]};
    }
}
DI void mini_proj(const Args& a, int l) {
    const int tid = lt_tid(), lane = tid & 63, wave = tid >> 6, r32 = lane & 31, hi = lane >> 5;
    const bf16_t* H = (const bf16_t*)(WSP(a) + WS_H); const bf16_t* W = (const bf16_t*)(WSP(a) + WS_WIN + (size_t)l * SZ_WIN1); bf16_t* P = (bf16_t*)(WSP(a) + WS_UP); float* PF = (float*)(WSP(a) + WS_PF);
    for (int it = blockIdx.x * 8 + wave; it < 8 * 97; it += gridDim.x * 8) { const int mt = it / 97, g = it % 97;
        f32x16 acc;
#pragma unroll
        for (int r = 0; r < 16; ++r) acc[r] = 0.f;
        mini_tile(H, DM, W, DM, NTP + 32 * mt, 32 * g, 0, 64, acc, r32, hi);
        const int rs = 32 * mt + r32, c0 = 32 * g + 4 * hi;
        bf16_t* pp = P + (size_t)(NTP + rs) * NPROJ + c0;
        float* dst = nullptr;
        if (g >= 8 && g < 16) dst = OUTP(a) + O_FKS + ((size_t)l * NTS + rs) * 256 + (c0 - 256);
        else if (g >= 16 && g < 24) dst = OUTP(a) + O_FVS + ((size_t)l * NTS + rs) * 256 + (c0 - 512);
        else if (g >= 64 && g < 80) dst = OUTP(a) + O_DKS + ((size_t)l * NTS + rs) * 512 + (c0 - 2048);
        else if (g >= 80 && g < 96) dst = OUTP(a) + O_DVS + ((size_t)l * NTS + rs) * 512 + (c0 - 2560);
        else if (g == 96) dst = PF + (size_t)(NTP + rs) * 32 + 4 * hi;
#pragma unroll
        for (int q = 0; q < 4; ++q) { u32x2 w; w.x = pk2(acc[4 * q], acc[4 * q + 1]); w.y = pk2(acc[4 * q + 2], acc[4 * q + 3]); *(u32x2*)(pp + 8 * q) = w;
            if (dst) *(f32x4*)(dst + 8 * q) = (f32x4){acc[4 * q], acc[4 * q + 1], acc[4 * q + 2], acc[4 * q + 3]}; }
    }
}

constexpr int N_PHASES = 32;
#ifndef PHM
#define PHM 0xffff
#endif
#define EN(b) ((PHM >> (b)) & 1)
__global__ void __launch_bounds__(512, 2) hybrid_fwd(Args a) {
    LAS unsigned char* lds_base = (LAS unsigned char*)lds_raw;
    { const unsigned hw = (unsigned)__builtin_amdgcn_s_getreg((5 << 11) | 4) & 63u;
      if ((threadIdx.x & 63) == 0) lds_base[LDS_WTAB + hw] = (unsigned char)(threadIdx.x >> 6);
      if (threadIdx.x < 2) ((LAS unsigned*)(lds_base + LDS_XBST))[threadIdx.x] = 0u;
      __syncthreads(); }
    (void)xcd_barrier_post((unsigned*)(WSP(a) + WS_BAR), (volatile LAS unsigned*)(lds_base + LDS_XBST));
    for (int pi = 0; pi < a.nph; ++pi) {
      { int pj = pi; asm volatile("" : "+s"(pj)); const int ph = a.plist[pj];
        unsigned char* ws = WSP(a);
        LAS unsigned char* lds = lnd(lds_base);
        if (ph == 0) { if (EN(0)) phase_prologue(a, lds); }
        else if (ph == 1) { if (EN(1)) phase_rows(a, 0, -1, 0.f, 0, 0, true); }
        else if (ph >= 100) { }
        else {
            const int l = (ph - 2) / 15, kp = (ph - 2) % 15;
            const int k = kp == 0 ? 0 : kp == 2 ? 1 : kp == 3 ? 2 : kp == 4 ? 3 : kp == 5 ? 4 : kp == 6 ? 5 : kp == 7 ? 6 : kp == 9 ? 7 : kp == 10 ? 8 : kp == 11 ? 9 : kp == 13 ? 10 : kp == 14 ? 11 : -1;
            if (kp == 1 || kp == 12) mini_f32(a, (const bf16_t*)(ws + WS_UP), DFF, (const bf16_t*)(ws + WS_WFO + (size_t)(l * 2 + (kp == 12)) * SZ_WFO1), DFF);
            else if (kp == 8) { phase_diff_combine(a, l); mini_f32(a, (const bf16_t*)(ws + WS_H), DM, (const bf16_t*)(ws + WS_WOUT + (size_t)l * SZ_WOUT1), DM); }
            else if (k == 0 || k == 9) { if (EN(2)) {
                const int i = (k == 9);
                pg8::Gemm g{(const bf16_t*)(ws + WS_H), (const bf16_t*)(ws + WS_WFI + (size_t)(l * 2 + i) * SZ_WFI1), MTOT, 2 * DFF, DM};
                pg8::StaticOrder S; S.init(MTOT, 2 * DFF, gridDim.x, blockIdx.x);
                EpiSwiglu E{(bf16_t*)(ws + WS_UP)};
                pg8::gemm_phase<EpiSwiglu, pg8::StaticOrder, true, true>(lds, g, S, E); }
            } else if (k == 1 || k == 10 || k == 7) { if (EN(3)) {
                const int i = (k == 10);
                pg8::Gemm g{k == 7 ? (const bf16_t*)(ws + WS_H) : (const bf16_t*)(ws + WS_UP),
                            k == 7 ? (const bf16_t*)(ws + WS_WOUT + (size_t)l * SZ_WOUT1) : (const bf16_t*)(ws + WS_WFO + (size_t)(l * 2 + i) * SZ_WFO1), NTP, DM, k == 7 ? DM : DFF};
                pg8::StaticOrder S; S.init(NTP, DM, gridDim.x, blockIdx.x);
                EpiF32 E{(bf16_t*)(ws + WS_Y)};
                pg8::gemm_phase<EpiF32, pg8::StaticOrder, true, true>(lds, g, S, E);
#ifdef MINI_IN_GEMM
                if (k != 7) mini_f32(a, (const bf16_t*)(WSP(a) + WS_UP), DFF, (const bf16_t*)(WSP(a) + WS_WFO + (size_t)(l * 2 + i) * SZ_WFO1), DFF);
#endif
                }
            } else if (k == 3) { if (EN(4)) {
                pg8::Gemm g{(const bf16_t*)(ws + WS_H), (const bf16_t*)(ws + WS_WIN + (size_t)l * SZ_WIN1), MTOT, NPROJ, DM};
                pg8::StaticOrder S; S.init(MTOT, NPROJ, gridDim.x, blockIdx.x);
                EpiProj E{(bf16_t*)(ws + WS_UP), OUTP(a), (float*)(ws + WS_PF), l};
                pg8::gemm_phase<EpiProj, pg8::StaticOrder, true, true>(lds, g, S, E); }
            } else if (k == 2) { if (EN(1)) phase_rows(a, l, 0, 0.5f, 1, l, l == 0); }
            else if (k == 8) { if (EN(1)) phase_rows(a, l, 1, 1.0f, 2, l, false); }
            else if (k == 11) { if (EN(1)) phase_rows(a, l, 2, 0.5f, l == 0 ? 0 : -1, 1, false); }
            else if (k == 4) { if (EN(5)) { const int tid = lt_tid(), lane = tid & 63, wave = tid >> 6;
                for (int it = wave * gridDim.x + blockIdx.x; it < 516 + 512; it += gridDim.x * 8) { if (it < 516) logf_item(a, l, it >> 2, it & 3, lane); else kn_item(a, l, it - 516, lane); }
                for (int it = blockIdx.x; it < 512; it += gridDim.x) gla_local_item(a, lds, l, it >> 8, it & 255); }
            } else if (k == 5) { const int tid = lt_tid(), lane = tid & 63, wave = tid >> 6;
                for (int it = blockIdx.x; it < 40; it += gridDim.x) {
                    if (it < 32) gla_scan_item(a, l, it);
                    else { const int wi = (it - 32) * 8 + wave; gla_sample_item(a, l, wi >> 2, wi & 3, lane); }
                }
            } else if (k == 6) {
                const int tid = lt_tid();
                LAS int* qslot = (LAS int*)(lds + LDS_BYTES - 16); unsigned* ctr = (unsigned*)(ws + WS_LAM) + 16 + pi;
                for (;;) {
                    __syncthreads();
                    if (tid == 0) qslot[0] = (int)atomicAdd(ctr, 1u);
                    __syncthreads();
                    const int it = qslot[0];
                    if (it >= 2176) break;
                    if (it >= 256 && it < 320) fox_sample_item(a, lds, l, (it - 256) >> 2, (it - 256) & 3);
                    else if (it >= 320 && it < 384) diff_sample_item(a, lds, l, (it - 320) >> 2, (it - 320) & 3);
                    else if (it < 1152) { const int j = it < 256 ? it : it - 128, rem = j & 255; diff_pass_unit(a, lds, l, (rem >> 1) & 1, 3 - (j >> 8), 63 - (rem >> 2), rem & 1);
#ifdef PROBE_DIFF2
                        diff_pass_unit(a, lds, l, (rem >> 1) & 1, 3 - (j >> 8), 63 - (rem >> 2), rem & 1);
#endif
                    }
                    else if (it < 1664) { const int j = it - 1152; fox_unit(a, lds, l, j >> 8, (j >> 6) & 3, 63 - (j & 63)); }
                    else { const int j = (it - 1664) * 4;
                        for (int hh = 0; hh < 4; ++hh) gla_out_item(a, lds, l, j >> 10, (j >> 2) & 255, hh);
                    }
                }
            }
        }
      }
      if (pi + 1 < a.nph) {
          if (a.nph > 4096) cg::this_grid().sync();
          else { XcdBarrier bar; bar.bar = (unsigned*)(WSP(a) + WS_BAR); bar.x = xb_xcc_id(); bar.st = (volatile LAS unsigned*)(lds_base + LDS_XBST); xcd_barrier(bar); }
      }
    }
}

#ifndef MK_LAUNCHES
#define MK_LAUNCHES 1
#endif
extern "C" void kernel_launch(void* const* d_in, const int* in_sizes, int n_in, void* d_out, int out_size, void* d_ws, size_t ws_size, hipStream_t stream) {
    static int grid = 0;
    if (grid == 0) {
        if (n_in != 23 || (size_t)out_size != O_END || ws_size < WS_END) { fprintf(stderr, "kernel_launch: unexpected shapes (n_in %d out %d ws %zu need %zu)\n", n_in, out_size, ws_size, (size_t)WS_END); grid = -1; return; }
        int dev = 0, cus = 0, per_cu = 0;
        hipGetDevice(&dev); hipDeviceGetAttribute(&cus, hipDeviceAttributeMultiprocessorCount, dev);
        if (hipFuncSetAttribute((const void*)hybrid_fwd, hipFuncAttributeMaxDynamicSharedMemorySize, LDS_BYTES) != hipSuccess) { fprintf(stderr, "kernel_launch: hipFuncSetAttribute failed\n"); grid = -1; return; }
        if (hipOccupancyMaxActiveBlocksPerMultiprocessor(&per_cu, (const void*)hybrid_fwd, 512, LDS_BYTES) != hipSuccess || per_cu < 1) { fprintf(stderr, "kernel_launch: occupancy query gave %d\n", per_cu); per_cu = 1; }
        (void)hipGetLastError();
        grid = cus * per_cu; if (grid > 256) grid = 256;
        fprintf(stderr, "kernel_launch: grid %d (cus %d per_cu %d)\n", grid, cus, per_cu);
    }
    if (grid < 0) return;
    Args a{};
    for (int i = 0; i < 23; ++i) a.in[i] = (const float*)d_in[i];
    a.out = (float*)d_out; a.ws = (unsigned char*)d_ws;
    int n = 0;
#ifdef PROBE_DUP
    for (int ph = 0; ph < N_PHASES; ++ph) { a.plist[n++] = (unsigned char)ph;
#ifdef PROBE_PH01
        if (ph < 2) a.plist[n++] = (unsigned char)ph;
#endif
        if (ph >= 2) { const int kk = (ph - 2) % 15; const int grp = (kk == 0 || kk == 2 || kk == 4 || kk == 9 || kk == 11 || kk == 13) ? 1 : (kk >= 5 && kk <= 7) ? 2 : 4;
            if (PROBE_DUP & grp) a.plist[n++] = (unsigned char)ph;
#ifdef PROBE_KK
            if ((PROBE_KK >> kk) & 1) a.plist[n++] = (unsigned char)ph;
#endif
        } }
#else
    for (int ph = 0; ph < N_PHASES; ++ph) {
#ifdef MINI_IN_GEMM
        if (ph >= 2 && ((ph - 2) % 15 == 1 || (ph - 2) % 15 == 12)) continue;
#endif
        a.plist[n++] = (unsigned char)ph; }
#endif
#ifdef PROBE_SYNC
    for (int i = 0; i < PROBE_SYNC; ++i) a.plist[n++] = (unsigned char)200;
#endif
    a.nph = n;
    if (hipMemsetAsync((char*)d_ws + WS_BAR, 0, 16384, stream) != hipSuccess) { fprintf(stderr, "kernel_launch: memset of barrier words failed\n"); return; }
    void* args[] = {&a};
    hipError_t e = hipLaunchCooperativeKernel((const void*)hybrid_fwd, dim3(grid), dim3(512), args, LDS_BYTES, stream);
    if (e != hipSuccess) fprintf(stderr, "cooperative launch failed: %s (grid %d)\n", hipGetErrorString(e), grid);
}
```

```cpp
#include <hip/hip_runtime.h>
#include <hip/hip_cooperative_groups.h>
#include <hip/hip_bf16.h>
#include <cstdio>
#include <cstdint>
namespace cg = cooperative_groups;
extern __shared__ __attribute__((aligned(16))) unsigned char lds_raw[];
constexpr int LDS_WTAB = 147456 - 96;
__device__ __forceinline__ int lt_tid() {
    const unsigned hw = (unsigned)__builtin_amdgcn_s_getreg((5 << 11) | 4) & 63u;
    int w = ((const __attribute__((address_space(3))) unsigned char*)lds_raw)[LDS_WTAB + hw];
    unsigned z = 0u; asm volatile("" : "+v"(z));
    int t = (w << 6) | (int)__builtin_amdgcn_mbcnt_hi(~0u, __builtin_amdgcn_mbcnt_lo(~0u, z));
    asm volatile("" : "+v"(t)); return t;
}
namespace pg8 {
#define PG8_LAS __attribute__((address_space(3)))
typedef unsigned short bf16_t;
typedef short bf16x8 __attribute__((ext_vector_type(8)));
typedef float f32x4 __attribute__((ext_vector_type(4)));
typedef unsigned u32x4 __attribute__((ext_vector_type(4)));
constexpr int BM = 256, BK = 64, HALF = 128, HTB = HALF * BK * 2  , STAGE_BYTES = 8 * HTB, NXCD = 8, WGM = 8;

__host__ __device__ __forceinline__ int lds_byte(int r, int c) { const int st = (r >> 4) * 2 + (c >> 5), rr = r & 15, cc = c & 31, ob = rr * 64 + cc * 2; return st * 1024 + (ob ^ (((ob >> 9) & 1) << 5)); }
__host__ __device__ __forceinline__ void stage_rc(int b, int& R, int& C) { const int st = b / 1024, sb = b % 1024, swz = sb ^ (((sb >> 9) & 1) << 5); R = (st >> 1) * 16 + swz / 64; C = (st & 1) * 32 + (swz % 64) / 2; }
__host__ __device__ __forceinline__ int perm32(int rho) { const int n = rho >> 4, i = rho & 15; return 8 * (i >> 2) + 4 * n + (i & 3); }

struct Unit { int pm, pn; };
struct Gemm { const bf16_t* A; const bf16_t* Bt; int M, N, K; };

struct StaticOrder {
    int nM, nN, nwg, G, c;
    __host__ __device__ void init(int M, int N, int G_, int c_) { nM = M / BM; nN = N / BM; nwg = nM * nN; G = G_; c = c_; }
    __host__ __device__ bool next(int i, Unit& u) const {
        const long L = (long)i * G + c; if (L >= nwg) return false;
        int wgid = (int)L; { const int q = nwg / NXCD, r = nwg % NXCD, xcd = wgid % NXCD, off = wgid / NXCD; wgid = (xcd < r ? xcd * (q + 1) : r * (q + 1) + (xcd - r) * q) + off; }
        const int nig = WGM * nN, gid = wgid / nig, fm = gid * WGM, gsz = (nM - fm) < WGM ? (nM - fm) : WGM;
        u.pm = fm + ((wgid % nig) % gsz); u.pn = (wgid % nig) / gsz; return true;
    }
    __device__ __forceinline__ void a_ready(const Unit&) const {}
    __device__ __forceinline__ void done(const Unit&) const {}
};

__device__ __forceinline__ unsigned cvt_pk_bf16(float lo, float hi) { unsigned r; asm volatile("v_cvt_pk_bf16_f32 %0, %1, %2" : "=v"(r) : "v"(lo), "v"(hi)); return r; }
template <class Epi, class Sched, bool ALIGN_EPI = false, bool SP2 = false>
__device__ __forceinline__ void gemm_phase(PG8_LAS unsigned char* lds, const Gemm g, const Sched& S, const Epi& E) {
    const int tid = lt_tid(), wid = __builtin_amdgcn_readfirstlane(tid >> 6), lane = tid & 63, wr = wid >> 2, wc = wid & 3, fr = lane & 15, fq = lane >> 4;
    const int K = g.K, nt = K / BK;
    unsigned voffA[2], voffB[2];
#pragma unroll
    for (int i = 0; i < 2; ++i) { int R, C; stage_rc(tid * 16 + i * 8192, R, C); const int Rb = Epi::PERM ? ((R & ~31) + perm32(R & 31)) : R;
        voffA[i] = (unsigned)(R * K + C) * 2u; voffB[i] = (unsigned)(Rb * K + C) * 2u; }
    const size_t kstep = (size_t)(BK * 2);
    const size_t hstep = (size_t)HALF * K * 2;
    const size_t tstep = 2 * hstep;
    const unsigned ldsw = (unsigned)wid * 1024u;
    const int aoff = lds_byte(wr * 64 + fr, fq * 8), boff = lds_byte(wc * 32 + fr, fq * 8);
#define PG8_SA(b, h) (((b) * 2 + (h)) * HTB)
#define PG8_SB(b, h) ((4 + (b) * 2 + (h)) * HTB)
#define PG8_STAGE(bufoff, gbase, voff) do { _Pragma("unroll") for (int _i = 0; _i < 2; ++_i) \
        __builtin_amdgcn_global_load_lds((const unsigned*)((const char*)(gbase) + (voff)[_i]), (PG8_LAS unsigned*)(lds + (bufoff) + ldsw + _i * 8192), 16, 0, 0); } while (0)
#define PG8_LDA(dst, b, h) do { _Pragma("unroll") for (int m = 0; m < 4; ++m) _Pragma("unroll") for (int k = 0; k < 2; ++k) dst[m][k] = *(const PG8_LAS bf16x8*)(lds + PG8_SA(b, h) + aoff + m * 2048 + k * 1024); } while (0)
#define PG8_LDB(dst, b, h) do { _Pragma("unroll") for (int n = 0; n < 2; ++n) _Pragma("unroll") for (int k = 0; k < 2; ++k) dst[n][k] = *(const PG8_LAS bf16x8*)(lds + PG8_SB(b, h) + boff + n * 2048 + k * 1024); } while (0)
#define PG8_MMA(ai, bj, At, Bt) do { __builtin_amdgcn_s_setprio(1); _Pragma("unroll") for (int m = 0; m < 4; ++m) _Pragma("unroll") for (int n = 0; n < 2; ++n) _Pragma("unroll") for (int k = 0; k < 2; ++k) \
        acc[ai][bj][m][n] = __builtin_amdgcn_mfma_f32_16x16x32_bf16(Bt[n][k], At[m][k], acc[ai][bj][m][n], 0, 0, 0); __builtin_amdgcn_s_setprio(0); } while (0)
#define PG8_WAIT_V(n) asm volatile("s_waitcnt vmcnt(" #n ")" ::: "memory")
#define PG8_WAIT_L(n) asm volatile("s_waitcnt lgkmcnt(" #n ")" ::: "memory")
#define PG8_BAR __builtin_amdgcn_s_barrier()
#define PG8_SCHED __builtin_amdgcn_sched_barrier(0)
    Unit cur, nxt; int ui = 0;
    if (!S.next(0, cur)) return;
    f32x4 acc[2][2][4][2];
#pragma unroll
    for (int a = 0; a < 2; ++a)
#pragma unroll
        for (int b = 0; b < 2; ++b)
#pragma unroll
            for (int m = 0; m < 4; ++m)
#pragma unroll
                for (int n = 0; n < 2; ++n) acc[a][b][m][n] = (f32x4){0.f, 0.f, 0.f, 0.f};
    bf16x8 At[4][2], B0[2][2], B1[2][2];
    const char* cA = (const char*)g.A + (size_t)cur.pm * tstep; const char* cB = (const char*)g.Bt + (size_t)cur.pn * tstep;
    S.a_ready(cur);
    if constexpr (SP2) {
        PG8_STAGE(PG8_SB(0, 0), cB, voffB); PG8_STAGE(PG8_SB(0, 1), cB + hstep, voffB); PG8_STAGE(PG8_SA(0, 0), cA, voffA); PG8_STAGE(PG8_SA(0, 1), cA + hstep, voffA);
        if (wr == 1) PG8_BAR;
        PG8_WAIT_V(2); PG8_BAR;
        PG8_STAGE(PG8_SB(1, 0), cB + kstep, voffB); PG8_STAGE(PG8_SA(1, 0), cA + kstep, voffA); PG8_STAGE(PG8_SB(1, 1), cB + hstep + kstep, voffB);
        PG8_WAIT_V(6); PG8_BAR;
    } else {
        PG8_STAGE(PG8_SB(0, 0), cB, voffB); PG8_STAGE(PG8_SA(0, 0), cA, voffA); PG8_STAGE(PG8_SB(0, 1), cB + hstep, voffB); PG8_STAGE(PG8_SA(0, 1), cA + hstep, voffA);
        if (wr == 1) PG8_BAR;
        PG8_WAIT_V(4); PG8_BAR;
        PG8_STAGE(PG8_SB(1, 0), cB + kstep, voffB); PG8_STAGE(PG8_SA(1, 0), cA + kstep, voffA); PG8_STAGE(PG8_SB(1, 1), cB + hstep + kstep, voffB);
        PG8_WAIT_V(6); PG8_BAR;
    }
    for (;;) {
        const bool has_next = S.next(ui + 1, nxt);
        const char* nA = has_next ? (const char*)g.A + (size_t)nxt.pm * tstep : cA; const char* nB = has_next ? (const char*)g.Bt + (size_t)nxt.pn * tstep : cB;
        for (int t = 0; t < nt; t += 2) {
            const bool last = (t == nt - 2);
            const char* a1 = cA + (size_t)(t + 1) * kstep;
            const char* a2 = last ? nA : cA + (size_t)(t + 2) * kstep; const char* b2 = last ? nB : cB + (size_t)(t + 2) * kstep;
            const char* a3 = a2 + kstep; const char* b3 = b2 + kstep;
            if (last && has_next) S.a_ready(nxt);
            if constexpr (SP2) {
            PG8_LDB(B0, 0, 0); PG8_LDB(B1, 0, 1); PG8_SCHED; PG8_LDA(At, 0, 0); PG8_STAGE(PG8_SA(1, 1), a1 + hstep, voffA);
            PG8_WAIT_V(8); PG8_WAIT_L(0); PG8_BAR; PG8_MMA(0, 0, At, B0); PG8_MMA(0, 1, At, B1); PG8_BAR; PG8_SCHED;
            PG8_LDA(At, 0, 1); PG8_STAGE(PG8_SB(0, 0), b2, voffB); PG8_STAGE(PG8_SB(0, 1), b2 + hstep, voffB); PG8_STAGE(PG8_SA(0, 0), a2, voffA);
            PG8_WAIT_V(8); PG8_WAIT_L(0); PG8_BAR; PG8_MMA(1, 0, At, B0); PG8_MMA(1, 1, At, B1); PG8_BAR; PG8_SCHED;
            PG8_LDB(B0, 1, 0); PG8_LDB(B1, 1, 1); PG8_SCHED; PG8_LDA(At, 1, 0); PG8_STAGE(PG8_SA(0, 1), a2 + hstep, voffA);
            PG8_WAIT_V(8); PG8_WAIT_L(0); PG8_BAR; PG8_MMA(0, 0, At, B0); PG8_MMA(0, 1, At, B1); PG8_BAR; PG8_SCHED;
            PG8_LDA(At, 1, 1); PG8_STAGE(PG8_SB(1, 0), b3, voffB); PG8_STAGE(PG8_SB(1, 1), b3 + hstep, voffB); PG8_STAGE(PG8_SA(1, 0), a3, voffA);
            PG8_WAIT_V(8); PG8_WAIT_L(0); PG8_BAR; PG8_MMA(1, 0, At, B0); PG8_MMA(1, 1, At, B1); PG8_BAR; PG8_SCHED;
            } else {
            PG8_LDB(B0, 0, 0); PG8_SCHED; PG8_LDA(At, 0, 0); PG8_STAGE(PG8_SA(1, 1), a1 + hstep, voffA);
            PG8_WAIT_L(8); PG8_BAR; PG8_WAIT_L(0); PG8_MMA(0, 0, At, B0); PG8_BAR; PG8_SCHED;
            PG8_LDB(B1, 0, 1); PG8_STAGE(PG8_SB(0, 0), b2, voffB);
            PG8_BAR; PG8_WAIT_L(0); PG8_MMA(0, 1, At, B1); PG8_BAR;
            PG8_LDA(At, 0, 1); PG8_STAGE(PG8_SA(0, 0), a2, voffA);
            PG8_BAR; PG8_WAIT_L(0); PG8_MMA(1, 0, At, B0); PG8_BAR; PG8_SCHED;
            PG8_STAGE(PG8_SB(0, 1), b2 + hstep, voffB);
            PG8_WAIT_V(6); PG8_BAR; PG8_MMA(1, 1, At, B1); PG8_BAR;
            PG8_LDB(B0, 1, 0); PG8_SCHED; PG8_LDA(At, 1, 0); PG8_STAGE(PG8_SA(0, 1), a2 + hstep, voffA);
            PG8_WAIT_L(8); PG8_BAR; PG8_WAIT_L(0); PG8_MMA(0, 0, At, B0); PG8_BAR; PG8_SCHED;
            PG8_LDB(B1, 1, 1); PG8_STAGE(PG8_SB(1, 0), b3, voffB);
            PG8_BAR; PG8_WAIT_L(0); PG8_MMA(0, 1, At, B1); PG8_BAR;
            PG8_LDA(At, 1, 1); PG8_STAGE(PG8_SA(1, 0), a3, voffA);
            PG8_BAR; PG8_WAIT_L(0); PG8_MMA(1, 0, At, B0); PG8_BAR; PG8_SCHED;
            PG8_STAGE(PG8_SB(1, 1), b3 + hstep, voffB);
            PG8_WAIT_V(6); PG8_BAR; PG8_MMA(1, 1, At, B1); PG8_BAR;
            }
        }
        if constexpr (ALIGN_EPI) { if (wr == 0) PG8_BAR; }
        if constexpr (!Epi::AFTER_DRAIN) { E(acc, cur, wr, wc, fr, fq); S.done(cur); }
        if (!has_next) break;
#pragma unroll
        for (int a = 0; a < 2; ++a)
#pragma unroll
            for (int b = 0; b < 2; ++b)
#pragma unroll
                for (int m = 0; m < 4; ++m)
#pragma unroll
                    for (int n = 0; n < 2; ++n) acc[a][b][m][n] = (f32x4){0.f, 0.f, 0.f, 0.f};
        cur = nxt; cA = nA; cB = nB; ++ui;
        if constexpr (ALIGN_EPI) { if (wr == 1) PG8_BAR; }
    }
    PG8_WAIT_V(0);
    if constexpr (!ALIGN_EPI) { if (wr == 0) PG8_BAR; }
    PG8_BAR;
    if constexpr (Epi::AFTER_DRAIN) { E.fused(acc, cur, wr, wc, fr, fq, lds, wid, lane); S.done(cur); }
#undef PG8_SA
#undef PG8_SB
#undef PG8_STAGE
#undef PG8_LDA
#undef PG8_LDB
#undef PG8_MMA
#undef PG8_WAIT_V
#undef PG8_WAIT_L
#undef PG8_BAR
#undef PG8_SCHED
}
}

#define DI __device__ __forceinline__
#define LAS __attribute__((address_space(3)))
typedef unsigned short bf16_t;
typedef short bf16x8 __attribute__((ext_vector_type(8)));
typedef short s16x4 __attribute__((ext_vector_type(4)));
typedef float f32x4 __attribute__((ext_vector_type(4)));
typedef float f32x16 __attribute__((ext_vector_type(16)));
typedef unsigned u32x4 __attribute__((ext_vector_type(4)));
typedef unsigned u32x2 __attribute__((ext_vector_type(2)));

constexpr int DM = 1024, SEQ = 16384, NTP = 32768, NTS = 256, MTOT = 33024, DFF = 2816, NPROJ = 3328, NSEQ = 18, NMOD = 9216;
constexpr float EPS = 1e-6f, LOG2E = 1.4426950408889634f, C2 = 0.125f * LOG2E, NEGBIG = -1e30f;
constexpr int PC_QA = 0, PC_KA = 256, PC_VA = 512, PC_QB = 768, PC_KB = 896, PC_VB = 1024, PC_RB = 1280, PC_QC = 1536, PC_KC = 2048, PC_VC = 2560;
constexpr size_t O_FKP = 33816576, O_FVP = O_FKP + 16777216, O_FLP = O_FVP + 16777216, O_GSP = O_FLP + 262144, O_DKP = O_GSP + 32768, O_DVP = O_DKP + 33554432,
                 O_FKS = O_DVP + 33554432, O_FVS = O_FKS + 131072, O_FLS = O_FVS + 131072, O_GSS = O_FLS + 2048, O_DKS = O_GSS + 262144, O_DVS = O_DKS + 262144, O_END = O_DVS + 262144;
static_assert(O_END == 135825408, "output map");
constexpr size_t SZ_WFI1 = (size_t)5632 * 1024 * 2, SZ_WFO1 = (size_t)1024 * 2816 * 2, SZ_WIN1 = (size_t)3328 * 1024 * 2, SZ_WOUT1 = (size_t)1024 * 1024 * 2;
constexpr size_t WS_WFI = 0, WS_WFO = WS_WFI + 4 * SZ_WFI1, WS_WIN = WS_WFO + 4 * SZ_WFO1, WS_WOUT = WS_WIN + 2 * SZ_WIN1, WS_MOD = WS_WOUT + 2 * SZ_WOUT1;
constexpr size_t WS_LAM = WS_MOD + (size_t)2 * NSEQ * NMOD * 4, WS_H = WS_LAM + 1024, WS_UP = WS_H + (size_t)MTOT * 1024 * 2, WS_Y = WS_UP + (size_t)MTOT * NPROJ * 2;
constexpr size_t WS_PF = WS_Y, WS_CLOC = WS_PF + (size_t)MTOT * 32 * 4, WS_CTOT = WS_CLOC + (size_t)NTP * 4 * 4, WS_CB = WS_CTOT + 4096, WS_GU = WS_CB + (size_t)NTP * 128 * 4;
constexpr size_t WS_GS = WS_GU + (size_t)2048 * 2048 * 4, WS_GDEC = WS_GS + (size_t)2048 * 2048 * 4, WS_OSCR = WS_GDEC + (size_t)2048 * 32 * 4, WS_MIXEND = WS_OSCR + (size_t)2 * NTP * 512 * 2;
constexpr size_t WS_YS = WS_Y + (size_t)MTOT * 1024 * 4;
constexpr size_t WS_BAR = WS_YS + (size_t)8 * NTS * 1024 * 4;
constexpr size_t WS_END = WS_BAR + 16384;
static_assert(WS_MIXEND <= WS_YS && (WS_H % 256) == 0 && (WS_UP % 256) == 0 && (WS_Y % 256) == 0, "ws map");
constexpr int LDS_BYTES = 147456, LDS_XBST = 147456 - 112;

struct Args { const float* in[23]; float* out; unsigned char* ws; int nph; unsigned char plist[60]; };
static_assert(sizeof(Args) == 264, "Args has no padding");
enum { I_XP = 0, I_XS, I_CP, I_CS, I_CFK, I_CFV, I_CFL, I_SG, I_CDK, I_CDV, I_WADA, I_BADA, I_GN, I_WFI, I_WFO, I_WIN, I_BF, I_WGU, I_BGU, I_GGLA, I_GDIFF, I_LAMP, I_WOUT };

DI const float* ain_(const Args& a, int i) { asm volatile("" : "+s"(i)); return a.in[i]; }
#define AIN(a, i) ain_(a, i)
DI unsigned char* wsp_(const Args& a) { unsigned char* p = a.ws; asm volatile("" : "+s"(p)); return p; }
DI float* outp_(const Args& a) { float* p = a.out; asm volatile("" : "+s"(p)); return p; }
#define WSP(a) wsp_(a)
#define OUTP(a) outp_(a)
DI LAS unsigned char* lnd(LAS unsigned char* p) { asm volatile("" : "+s"(p)); return p; }
DI float one_minus_lam_init(int l) { const unsigned bits = (l == 0) ? 0x3f4ccccdu : 0x3f24fd5cu; return __uint_as_float(bits); }
DI float bf2f(bf16_t b) { return __uint_as_float((unsigned)b << 16); }
DI unsigned pk2(float lo, float hi) { return pg8::cvt_pk_bf16(lo, hi); }
DI float silu_f(float x) { return x / (1.f + __expf(-x)); }
DI float silu_fast(float x) { return x * __builtin_amdgcn_rcpf(1.f + __expf(-x)); }
DI float logsig(float x) { return fminf(x, 0.f) - log1pf(__expf(-fabsf(x))); }
DI float wave_sum(float v) {
#pragma unroll
    for (int o = 1; o < 64; o <<= 1) v += __shfl_xor(v, o);
    return v;
}
DI float wave_max(float v) {
#pragma unroll
    for (int o = 1; o < 64; o <<= 1) v = fmaxf(v, __shfl_xor(v, o));
    return v;
}
DI float half_max(float v) { auto rr = __builtin_amdgcn_permlane32_swap(__float_as_uint(v), __float_as_uint(v), false, false); return fmaxf(__uint_as_float(rr[0]), __uint_as_float(rr[1])); }
DI float half_sum(float v) { auto rr = __builtin_amdgcn_permlane32_swap(__float_as_uint(v), __float_as_uint(v), false, false); return __uint_as_float(rr[0]) + __uint_as_float(rr[1]); }
DI int seq_of(int m) { return m < NTP ? (m >> 14) : 2 + ((m - NTP) >> 4); }
DI int crow(int r, int hi) { return (r & 3) + 8 * (r >> 2) + 4 * hi; }

struct EpiSwiglu {
    static constexpr bool PERM = true, AFTER_DRAIN = false;
    bf16_t* U;
    DI void operator()(const pg8::f32x4 (&acc)[2][2][4][2], const pg8::Unit& u, int wr, int wc, int fr, int fq) const {
        const int row0 = u.pm * 256 + wr * 64 + fr, col0 = u.pn * 128 + wc * 32 + 8 * fq;
#pragma unroll
        for (int ai = 0; ai < 2; ++ai)
#pragma unroll
            for (int m = 0; m < 4; ++m) {
                const pg8::f32x4 g0 = acc[ai][0][m][0], g1 = acc[ai][0][m][1], u0 = acc[ai][1][m][0], u1 = acc[ai][1][m][1];
                u32x4 w;
                w.x = pk2(silu_fast(g0[0]) * u0[0], silu_fast(g0[1]) * u0[1]); w.y = pk2(silu_fast(g0[2]) * u0[2], silu_fast(g0[3]) * u0[3]);
                w.z = pk2(silu_fast(g1[0]) * u1[0], silu_fast(g1[1]) * u1[1]); w.w = pk2(silu_fast(g1[2]) * u1[2], silu_fast(g1[3]) * u1[3]);
                *(u32x4*)(U + (size_t)(row0 + ai * 128 + m * 16) * DFF + col0) = w;
            }
    }
};
struct EpiF32 {
    static constexpr bool PERM = true, AFTER_DRAIN = false;
    bf16_t* Y;
    DI void operator()(const pg8::f32x4 (&acc)[2][2][4][2], const pg8::Unit& u, int wr, int wc, int fr, int fq) const {
        const int row0 = u.pm * 256 + wr * 64 + fr, col0 = u.pn * 256 + wc * 32 + 8 * fq;
#pragma unroll
        for (int ai = 0; ai < 2; ++ai)
#pragma unroll
            for (int m = 0; m < 4; ++m) {
                bf16_t* rp = Y + (size_t)(row0 + ai * 128 + m * 16) * DM + col0;
#pragma unroll
                for (int bj = 0; bj < 2; ++bj) { const pg8::f32x4 v0 = acc[ai][bj][m][0], v1 = acc[ai][bj][m][1];
                    u32x4 w; w.x = pk2(v0[0], v0[1]); w.y = pk2(v0[2], v0[3]); w.z = pk2(v1[0], v1[1]); w.w = pk2(v1[2], v1[3]);
                    *(u32x4*)(rp + bj * 128) = w; }
            }
    }
};
struct EpiProj {
    static constexpr bool PERM = true, AFTER_DRAIN = false;
    bf16_t* P; float* out; float* PF; int l;
    DI void operator()(const pg8::f32x4 (&acc)[2][2][4][2], const pg8::Unit& u, int wr, int wc, int fr, int fq) const {
        const int pn = u.pn; const bool samp = (u.pm == 128);
        float* dst = nullptr; int W = 0, cbase = 0;
        if (pn == 1) { dst = out + (samp ? O_FKS : O_FKP); W = 256; }
        else if (pn == 2) { dst = out + (samp ? O_FVS : O_FVP); W = 256; }
        else if (pn == 8 || pn == 9) { dst = out + (samp ? O_DKS : O_DKP); W = 512; cbase = (pn - 8) * 256; }
        else if (pn == 10 || pn == 11) { dst = out + (samp ? O_DVS : O_DVP); W = 512; cbase = (pn - 10) * 256; }
        const size_t lrows = samp ? (size_t)l * NTS : (size_t)l * NTP; const int rbase = samp ? NTP : 0;
#pragma unroll
        for (int ai = 0; ai < 2; ++ai)
#pragma unroll
            for (int m = 0; m < 4; ++m) {
                const int row = u.pm * 256 + ai * 128 + wr * 64 + m * 16 + fr;
#pragma unroll
                for (int bj = 0; bj < 2; ++bj) {
                    const int ct = bj * 128 + wc * 32 + 8 * fq;
                    const pg8::f32x4 v0 = acc[ai][bj][m][0], v1 = acc[ai][bj][m][1];
                    u32x4 w; w.x = pk2(v0[0], v0[1]); w.y = pk2(v0[2], v0[3]); w.z = pk2(v1[0], v1[1]); w.w = pk2(v1[2], v1[3]);
                    if (pn != 12) *(u32x4*)(P + (size_t)row * NPROJ + pn * 256 + ct) = w;
                    if (dst) { float* d = dst + (lrows + (size_t)(row - rbase)) * W + cbase + ct; *(f32x4*)d = v0; *(f32x4*)(d + 4) = v1; }
                    if (pn == 12 && ct < 32) { float* d = PF + (size_t)row * 32 + ct; *(f32x4*)d = v0; *(f32x4*)(d + 4) = v1; }
                }
            }
    }
};

DI int srccol(int mode, int d) {
    if (mode == 0) return d;
    if (mode == 1) { const int t = d >> 8, w = d & 255; return w < 128 ? t * 128 + w : DFF + t * 128 + (w - 128); }
    if (d < 768) return d;
    if (d < 1280) return d + 4;
    if (d < 3072) return d + 20;
    if (d < 3076) return 768 + (d - 3072);
    if (d < 3092) return 1284 + (d - 3076);
    return -1;
}
DI void tr_item(const float* W, int K, int Nsrc, bf16_t* WT, int mode, LAS float* scr, int kb, int db, int lane) {
    const int k0 = 64 * kb, d0 = 32 * db, sc = srccol(mode, d0 + (lane & 31));
#pragma unroll 16
    for (int i = 0; i < 32; ++i) { const int kk = 2 * i + (lane >> 5); scr[kk * 33 + (lane & 31)] = sc >= 0 ? W[(size_t)(k0 + kk) * Nsrc + sc] : 0.f; }
    asm volatile("s_waitcnt lgkmcnt(0)" ::: "memory");
    const int c = lane & 7;
#pragma unroll
    for (int j = 0; j < 4; ++j) { const int n = (lane >> 3) + 8 * j; const LAS float* s = scr + (8 * c) * 33 + n;
        u32x4 o; o.x = pk2(s[0 * 33], s[1 * 33]); o.y = pk2(s[2 * 33], s[3 * 33]); o.z = pk2(s[4 * 33], s[5 * 33]); o.w = pk2(s[6 * 33], s[7 * 33]);
        *(u32x4*)(WT + (size_t)(d0 + n) * K + k0 + 8 * c) = o; }
    asm volatile("s_waitcnt lgkmcnt(0)" ::: "memory");
}
constexpr int TR_I_FI = 16 * 176, TR_I_FO = 44 * 32, TR_I_IN = 16 * 104, TR_I_OUT = 16 * 32;
constexpr int TR_ITEMS_PER_LAYER = 2 * TR_I_FI + 2 * TR_I_FO + TR_I_IN + TR_I_OUT;
DI void tr_layer_item(const Args& a, LAS unsigned char* lds, int layer, int r, int wave, int lane) {
    LAS float* scr = (LAS float*)(lds) + wave * (64 * 33); unsigned char* ws = WSP(a);
    if (r < 2 * TR_I_FI) { const int mi = layer * 2 + r / TR_I_FI, q = r % TR_I_FI; tr_item(AIN(a, I_WFI) + (size_t)mi * 1024 * 5632, 1024, 5632, (bf16_t*)(ws + WS_WFI + mi * SZ_WFI1), 1, scr, q / 176, q % 176, lane); return; }
    r -= 2 * TR_I_FI;
    if (r < 2 * TR_I_FO) { const int mi = layer * 2 + r / TR_I_FO, q = r % TR_I_FO; tr_item(AIN(a, I_WFO) + (size_t)mi * 2816 * 1024, 2816, 1024, (bf16_t*)(ws + WS_WFO + mi * SZ_WFO1), 0, scr, q / 32, q % 32, lane); return; }
    r -= 2 * TR_I_FO;
    if (r < TR_I_IN) { tr_item(AIN(a, I_WIN) + (size_t)layer * 1024 * 3092, 1024, 3092, (bf16_t*)(ws + WS_WIN + layer * SZ_WIN1), 2, scr, r / 104, r % 104, lane); return; }
    r -= TR_I_IN;
    tr_item(AIN(a, I_WOUT) + (size_t)layer * 1024 * 1024, 1024, 1024, (bf16_t*)(ws + WS_WOUT + layer * SZ_WOUT1), 0, scr, r / 32, r % 32, lane);
}
DI void phase_prologue(const Args& a, LAS unsigned char* lds) {
    const int tid = lt_tid(), lane = tid & 63, wave = tid >> 6;
    unsigned char* ws = WSP(a);
    {
        LAS float* sc = (LAS float*)lds; LAS float* red = sc + NSEQ * 1024;
        bool have = false;
        for (int item = blockIdx.x; item < 576; item += gridDim.x) {
            if (!have) {
                for (int i = tid; i < NSEQ * 1024; i += 512) { const int s = i >> 10, k = i & 1023; const float c = s < 2 ? AIN(a, I_CP)[s * 1024 + k] : AIN(a, I_CS)[(s - 2) * 1024 + k]; sc[i] = silu_f(c); }
                have = true; __syncthreads();
            }
            const int l = item / 288, n0 = (item % 288) * 32, c4 = tid & 7, kg = tid >> 3;
            f32x4 acc[NSEQ];
#pragma unroll
            for (int s = 0; s < NSEQ; ++s) acc[s] = (f32x4){0.f, 0.f, 0.f, 0.f};
            const float* wp = AIN(a, I_WADA) + ((size_t)l * 1024 + kg * 16) * NMOD + n0 + 4 * c4;
#pragma unroll 8
            for (int k = 0; k < 16; ++k) { const f32x4 w = *(const f32x4*)(wp + (size_t)k * NMOD);
#pragma unroll
                for (int s = 0; s < NSEQ; ++s) acc[s] = acc[s] + w * sc[s * 1024 + kg * 16 + k]; }
#pragma unroll
            for (int s = 0; s < NSEQ; ++s)
#pragma unroll
                for (int c = 0; c < 4; ++c) { float v = acc[s][c]; v += __shfl_xor(v, 8); v += __shfl_xor(v, 16); v += __shfl_xor(v, 32); acc[s][c] = v; }
            if ((tid & 63) < 8) {
#pragma unroll
                for (int s = 0; s < NSEQ; ++s) *(LAS f32x4*)(red + ((tid >> 6) * NSEQ + s) * 32 + 4 * c4) = acc[s]; }
            __syncthreads();
            float* MOD = (float*)(ws + WS_MOD);
            for (int i = tid; i < NSEQ * 32; i += 512) { const int s = i >> 5, c = i & 31; float v = AIN(a, I_BADA)[l * NMOD + n0 + c];
#pragma unroll
                for (int g = 0; g < 8; ++g) v += red[(g * NSEQ + s) * 32 + c];
                MOD[((size_t)l * NSEQ + s) * NMOD + n0 + c] = v; }
            __syncthreads();
        }
        __syncthreads();
    }
    if (blockIdx.x == 0 && tid < 2) { const float* lp = AIN(a, I_LAMP) + tid * 256; float s0 = 0.f, s1 = 0.f;
        for (int i = 0; i < 64; ++i) { s0 += lp[i] * lp[64 + i]; s1 += lp[128 + i] * lp[192 + i]; }
        const float lam_init = 0.8f - 0.6f * expf(-0.3f * (float)tid);
        ((float*)(ws + WS_LAM))[tid] = expf(s0) - expf(s1) + lam_init; }
    if (blockIdx.x == 0 && tid >= 64 && tid < 64 + 112) ((unsigned*)(ws + WS_LAM))[16 + tid - 64] = 0u;
    const int gw = blockIdx.x * 8 + wave, NGW = gridDim.x * 8;
    for (int it = gw; it < 2 * TR_ITEMS_PER_LAYER; it += NGW) tr_layer_item(a, lds, it >= TR_ITEMS_PER_LAYER ? 1 : 0, it % TR_ITEMS_PER_LAYER, wave, lane);
}

struct RowVecs { f32x4 gpo[4], gpr[4], m2[4], m0[4], m1[4]; int cur_sq; };
DI void rows_load(const Args& a, int m, bool first, bool post, int lane, f32x4 (&x)[4], u32x2 (&y)[4]) {
    const float* xs = first ? (m < NTP ? AIN(a, I_XP) + (size_t)m * DM : AIN(a, I_XS) + (size_t)(m - NTP) * DM) : OUTP(a) + (size_t)m * DM;
#pragma unroll
    for (int j = 0; j < 4; ++j) x[j] = *(const f32x4*)(xs + 4 * lane + 256 * j);
    if (post) { const bf16_t* yr = (const bf16_t*)(WSP(a) + WS_Y) + (size_t)m * DM;
#pragma unroll
        for (int j = 0; j < 4; ++j) y[j] = *(const u32x2*)(yr + 4 * lane + 256 * j); }
}
DI void rows_process(const Args& a, int m, int l, int post_s, float res_w, int pre_s, int pre_l, int lane, f32x4 (&x)[4], const u32x2 (&yw)[4], RowVecs& V) {
    const int sq = seq_of(m);
    if (sq != V.cur_sq) { V.cur_sq = sq; const float* MOD = (const float*)(WSP(a) + WS_MOD);
        if (post_s >= 0) { const float* p2 = MOD + ((size_t)l * NSEQ + sq) * NMOD + (post_s * 3 + 2) * DM;
#pragma unroll
            for (int j = 0; j < 4; ++j) V.m2[j] = *(const f32x4*)(p2 + 4 * lane + 256 * j); }
        if (pre_s >= 0) { const float* mb = MOD + ((size_t)pre_l * NSEQ + sq) * NMOD + (pre_s * 3) * DM;
#pragma unroll
            for (int j = 0; j < 4; ++j) { V.m0[j] = *(const f32x4*)(mb + 4 * lane + 256 * j); V.m1[j] = *(const f32x4*)(mb + DM + 4 * lane + 256 * j); } } }
    if (post_s >= 0) {
        f32x4 y[4]; float ss = 0.f;
#pragma unroll
        for (int j = 0; j < 4; ++j) { y[j] = (f32x4){__uint_as_float(yw[j].x << 16), __uint_as_float(yw[j].x & 0xffff0000u), __uint_as_float(yw[j].y << 16), __uint_as_float(yw[j].y & 0xffff0000u)};
            if (m >= NTP) { const float* ys = (const float*)(WSP(a) + WS_YS) + (size_t)(m - NTP) * DM + 4 * lane + 256 * j; y[j] = *(const f32x4*)ys;
#pragma unroll
                for (int ks = 1; ks < 8; ++ks) y[j] = y[j] + *(const f32x4*)(ys + (size_t)ks * NTS * DM); }
            ss += (y[j].x * y[j].x + y[j].y * y[j].y) + (y[j].z * y[j].z + y[j].w * y[j].w); }
        const float ry = rsqrtf(wave_sum(ss) * (1.f / DM) + EPS) * res_w;
#pragma unroll
        for (int j = 0; j < 4; ++j) x[j] = x[j] + V.m2[j] * (y[j] * ry * V.gpo[j]);
        float* xd = OUTP(a) + (size_t)m * DM;
#pragma unroll
        for (int j = 0; j < 4; ++j) *(f32x4*)(xd + 4 * lane + 256 * j) = x[j];
    }
    if (pre_s >= 0) {
        float ss = 0.f;
#pragma unroll
        for (int j = 0; j < 4; ++j) ss += (x[j].x * x[j].x + x[j].y * x[j].y) + (x[j].z * x[j].z + x[j].w * x[j].w);
        const float rx = rsqrtf(wave_sum(ss) * (1.f / DM) + EPS);
        bf16_t* hr = (bf16_t*)(WSP(a) + WS_H) + (size_t)m * DM;
#pragma unroll
        for (int j = 0; j < 4; ++j) { const f32x4 hv = (x[j] * rx * V.gpr[j]) * (V.m1[j] + 1.f) + V.m0[j]; u32x2 w; w.x = pk2(hv.x, hv.y); w.y = pk2(hv.z, hv.w); *(u32x2*)(hr + 4 * lane + 256 * j) = w; }
    }
}
DI void phase_rows(const Args& a, int l, int post_s, float res_w, int pre_s, int pre_l, bool first) {
    const int tid = lt_tid(), lane = tid & 63, wave = tid >> 6;
    const int gw = blockIdx.x * 8 + wave, NGW = gridDim.x * 8;
    RowVecs V; V.cur_sq = -1;
#pragma unroll
    for (int j = 0; j < 4; ++j) { V.gpo[j] = V.gpr[j] = V.m2[j] = V.m0[j] = V.m1[j] = (f32x4){0.f, 0.f, 0.f, 0.f}; }
    if (post_s >= 0) { const float* g = AIN(a, I_GN) + (size_t)(l * 6 + 2 * post_s + 1) * DM;
#pragma unroll
        for (int j = 0; j < 4; ++j) V.gpo[j] = *(const f32x4*)(g + 4 * lane + 256 * j); }
    if (pre_s >= 0) { const float* g = AIN(a, I_GN) + (size_t)(pre_l * 6 + 2 * pre_s) * DM;
#pragma unroll
        for (int j = 0; j < 4; ++j) V.gpr[j] = *(const f32x4*)(g + 4 * lane + 256 * j); }
    constexpr int NR = 4;
    for (int m0 = gw; m0 < MTOT; m0 += NR * NGW) {
        f32x4 x[NR][4]; u32x2 y[NR][4];
#pragma unroll
        for (int r = 0; r < NR; ++r)
#pragma unroll
            for (int j = 0; j < 4; ++j) { y[r][j] = (u32x2){0u, 0u}; x[r][j] = (f32x4){0.f, 0.f, 0.f, 0.f}; }
#pragma unroll
        for (int r = 0; r < NR; ++r) if (m0 + r * NGW < MTOT) rows_load(a, m0 + r * NGW, first, post_s >= 0, lane, x[r], y[r]);
#pragma unroll
        for (int r = 0; r < NR; ++r) if (m0 + r * NGW < MTOT) rows_process(a, m0 + r * NGW, l, post_s, res_w, pre_s, pre_l, lane, x[r], y[r], V);
    }
}
#define XB_TMO      128
#define XB_XCNT(j)  (256  + 64 * (j))
#define XB_XSUB(j)  (1280 + 64 * (j))
#define XB_XGEN(j)  (2304 + 64 * (j))
#define XB_TOP      3328
#define XB_TOPGEN   3392
#define XCD_BAR_WORDS 3456
#define XB_SPIN_CAP (1u << 18)

__device__ __forceinline__ unsigned xb_ld(unsigned* p)              { return __hip_atomic_load(p, __ATOMIC_RELAXED, __HIP_MEMORY_SCOPE_AGENT); }
__device__ __forceinline__ unsigned xb_add(unsigned* p, unsigned v) { return __hip_atomic_fetch_add(p, v, __ATOMIC_RELAXED, __HIP_MEMORY_SCOPE_AGENT); }
__device__ __forceinline__ unsigned xb_xcc_id() { return (unsigned)__builtin_amdgcn_s_getreg((3 << 11) | 20) & 0xFu; }
#define XB_SPIN(cond, bar) do { unsigned _sp = 0; while (cond) { __builtin_amdgcn_s_sleep(1); \
    if ((++_sp & 255u) == 0u) { if (xb_ld(&(bar)[XB_TMO])) break; if (_sp > XB_SPIN_CAP) { atomicAdd(&(bar)[XB_TMO], 1u); break; } } } } while (0)

struct XcdBarrier {
    unsigned* bar; unsigned x;
    volatile LAS unsigned* st;
};

__device__ __forceinline__ XcdBarrier xcd_barrier_post(unsigned* bar, volatile LAS unsigned* st) {
    XcdBarrier b; b.bar = bar; b.x = xb_xcc_id(); b.st = st;
    if (lt_tid() == 0) (void)xb_add(&bar[XB_XCNT(b.x)], 1u);
    return b;
}
__device__ __forceinline__ void xcd_barrier_complete(unsigned* bar, unsigned x, unsigned& nloc, unsigned& nx) {
    const unsigned G = gridDim.x * gridDim.y * gridDim.z;
    unsigned sum, cnt, mine, sp = 0u;
    for (;;) {
        sum = 0u; cnt = 0u; mine = 0u;
#pragma unroll
        for (unsigned j = 0; j < 16; ++j) { const unsigned c = xb_ld(&bar[XB_XCNT(j)]); sum += c; cnt += (c > 0u) ? 1u : 0u; mine = (j == x) ? c : mine; }
        if (sum == G) break;
        __builtin_amdgcn_s_sleep(1);
        if ((++sp & 255u) == 0u) { if (xb_ld(&bar[XB_TMO])) break; if (sp > XB_SPIN_CAP) { atomicAdd(&bar[XB_TMO], 1u); break; } }
    }
    nloc = mine > 0u ? mine : 1u; nx = cnt > 0u ? cnt : 1u;
}

__device__ __forceinline__ void xcd_barrier(const XcdBarrier& b) {
    asm volatile("s_waitcnt vmcnt(0)" ::: "memory");
    __syncthreads();
    if (lt_tid() == 0) {
        unsigned* bar = b.bar;
        __builtin_amdgcn_s_waitcnt(0);
        unsigned nloc = b.st[0], nx = b.st[1];
        if (nloc == 0u) { xcd_barrier_complete(bar, b.x, nloc, nx); b.st[0] = nloc; b.st[1] = nx; }
        const unsigned old = xb_add(&bar[XB_XSUB(b.x)], 1u);
        const unsigned gen = old / nloc;
        if (old + 1u == (gen + 1u) * nloc) {
            __builtin_amdgcn_fence(__ATOMIC_RELEASE, "agent");
            asm volatile("s_waitcnt vmcnt(0)" ::: "memory");
            const unsigned og = xb_add(&bar[XB_TOP], 1u);
            const unsigned tg = og / nx;
            if (og + 1u == (tg + 1u) * nx) xb_add(&bar[XB_TOPGEN], 1u);
            else XB_SPIN(xb_ld(&bar[XB_TOPGEN]) == tg, bar);
            __builtin_amdgcn_fence(__ATOMIC_ACQUIRE, "agent");
            xb_add(&bar[XB_XGEN(b.x)], 1u);
            asm volatile("s_waitcnt vmcnt(0)" ::: "memory");
        } else {
            XB_SPIN(xb_ld(&bar[XB_XGEN(b.x)]) == gen, bar);
            __builtin_amdgcn_fence(__ATOMIC_ACQUIRE, "agent");
            asm volatile("s_waitcnt vmcnt(0)" ::: "memory");
        }
    }
    __syncthreads();
}

constexpr int KP = 144;
constexpr int AT_K = 0, AT_V = 64 * KP, AT_B = AT_V + 64 * 272, AT_BUF = AT_B + 256;
static_assert(4 * AT_BUF + 64 <= LDS_BYTES - 128 && (AT_BUF % 16) == 0, "attention LDS");
typedef short v4i16_t __attribute__((ext_vector_type(4)));
DI s16x4 vtr(const LAS unsigned char* p) { return __builtin_bit_cast(s16x4, __builtin_amdgcn_ds_read_tr16_b64_v4i16((LAS v4i16_t*)p)); }

template <int DV, bool FOX, int HH>
DI void attn_pass(LAS unsigned char* lds, const bf16_t* __restrict__ P, size_t rowbase, int q0, int qcol, int kcol, int vcol,
                  const float* __restrict__ cloc, const float* __restrict__ ctot_b, int h, float sb, f32x16 (&O)[DV / 32], float& l_out) {
    constexpr float slope_l2 = (HH == 0 ? 0.25f : HH == 1 ? 0.0625f : HH == 2 ? 0.015625f : 0.00390625f) * LOG2E;
    constexpr int VP = DV * 2 + 16, NVR = DV / 64;
    lds = lnd(lds);
    const int tid = lt_tid(), lane = tid & 63, w = __builtin_amdgcn_readfirstlane(tid >> 6), r32 = lane & 31, hi = lane >> 5;
    const int qrow = q0 + 32 * w + r32;
    bf16x8 qf[4];
    { const bf16_t* qp = P + (rowbase + qrow) * NPROJ + qcol + 8 * hi;
#pragma unroll
      for (int d0 = 0; d0 < 4; ++d0) qf[d0] = *(const bf16x8*)(qp + 16 * d0); }
    const int tmax_wg = (q0 >> 6) + 3, tmax_w = (q0 >> 6) + (w >> 1);
    float mrun = NEGBIG, lrun = 0.f;
    float ubase;
    { float qs = 0.f;
#pragma unroll
      for (int d0 = 0; d0 < 4; ++d0)
#pragma unroll
          for (int j = 0; j < 8; ++j) { const float v = bf2f((bf16_t)qf[d0][j]); qs += v * v; }
      qs = half_sum(qs); ubase = sb * wave_max(sqrtf(qs)) * 1.01f + 30.1f;
      ubase = __uint_as_float(__builtin_amdgcn_readfirstlane(__float_as_uint(ubase))); }
    bool done = false;
    const float hterm = FOX ? 0.f : slope_l2 * 4.f * (float)hi;
    LAS int* flags = (LAS int*)(lds + 4 * AT_BUF);
#pragma unroll
    for (int db = 0; db < DV / 32; ++db)
#pragma unroll
        for (int r = 0; r < 16; ++r) O[db][r] = 0.f;
    const int srow = tid >> 3, sch = tid & 7;
    u32x4 kregA, vregA[NVR], kregB, vregB[NVR]; float bregA = 0.f, bregB = 0.f; float Drun = 0.f; int kt_cur = q0 >> 8;
#define AT_ISSUE(S, t) do { const bf16_t* rp = P + (rowbase + 64 * (t) + srow) * NPROJ; \
        kreg##S = *(const u32x4*)(rp + kcol + 8 * sch); \
        _Pragma("unroll") for (int i_ = 0; i_ < NVR; ++i_) vreg##S[i_] = *(const u32x4*)(rp + vcol + 8 * (sch + 8 * i_)); \
        if (FOX) { const int kt_ = (t) >> 2; if (kt_ != kt_cur) { Drun += ctot_b[kt_ * 4 + h]; kt_cur = kt_; } \
                   if (tid < 64) breg##S = (Drun - cloc[(rowbase + 64 * (t) + tid) * 4 + h]) * LOG2E; } } while (0)
    AT_ISSUE(A, tmax_wg); AT_ISSUE(B, tmax_wg - 1);
    int it = 0, t = tmax_wg;
    for (;;) {
      {
        const int pr = it >> 1;
        LAS unsigned char* bufA = lds + ((pr & 1) * 2) * AT_BUF; LAS unsigned char* bufB = bufA + AT_BUF;
        *(LAS u32x4*)(bufA + AT_K + srow * KP + sch * 16) = kregA;
#pragma unroll
        for (int i = 0; i < NVR; ++i) *(LAS u32x4*)(bufA + AT_V + srow * VP + (sch + 8 * i) * 16) = vregA[i];
        if (FOX) { if (tid < 64) *(LAS float*)(bufA + AT_B + tid * 4) = bregA; }
        *(LAS u32x4*)(bufB + AT_K + srow * KP + sch * 16) = kregB;
#pragma unroll
        for (int i = 0; i < NVR; ++i) *(LAS u32x4*)(bufB + AT_V + srow * VP + (sch + 8 * i) * 16) = vregB[i];
        if (FOX) { if (tid < 64) *(LAS float*)(bufB + AT_B + tid * 4) = bregB; }
        asm volatile("s_waitcnt lgkmcnt(0)" ::: "memory"); __builtin_amdgcn_s_barrier(); asm volatile("" ::: "memory");
        if (pr > 0) { const LAS int* fl = flags + ((pr - 1) & 1) * 8; int all = 1;
#pragma unroll
            for (int i = 0; i < 8; ++i) all &= fl[i];
            if (all) break; }
        if (t > 1) AT_ISSUE(A, t - 2);
        if (t > 2) AT_ISSUE(B, t - 3);
        { LAS unsigned char* buf = bufA;
        if (t <= tmax_w && !done) {
            const float bmax = FOX ? ((const LAS float*)(buf + AT_B))[63] : slope_l2 * (float)(64 * t + 63 - q0);
            if (__all(ubase + bmax < mrun)) done = true;
        }
        if (t <= tmax_w && !done) {
            const float base_t = FOX ? 0.f : slope_l2 * (float)(64 * t - q0); float c32 = 0.f, hadd = 0.f;
            f32x16 s0, s1;
#pragma unroll
            for (int r = 0; r < 16; ++r) { s0[r] = 0.f; s1[r] = 0.f; }
            const LAS unsigned char* kb = buf + AT_K + r32 * KP + hi * 16;
            const LAS unsigned char* vb = buf + AT_V + (4 * hi + ((lane & 15) >> 2)) * VP + (16 * ((lane >> 4) & 1) + 4 * (lane & 3)) * 2;
            bf16x8 kf[8];
#pragma unroll
            for (int d0 = 0; d0 < 4; ++d0) { kf[2 * d0] = *(const LAS bf16x8*)(kb + d0 * 32); kf[2 * d0 + 1] = *(const LAS bf16x8*)(kb + 32 * KP + d0 * 32); }
            __builtin_amdgcn_sched_barrier(0);
#pragma unroll
            for (int d0 = 0; d0 < 4; ++d0) {
                s0 = __builtin_amdgcn_mfma_f32_32x32x16_bf16(kf[2 * d0], qf[d0], s0, 0, 0, 0);
                s1 = __builtin_amdgcn_mfma_f32_32x32x16_bf16(kf[2 * d0 + 1], qf[d0], s1, 0, 0, 0);
            }
            s16x4 vfa[8], vfb[8];
#define AT_RDV(dst, db) do { _Pragma("unroll") for (int ks_ = 0; ks_ < 4; ++ks_) { dst[2 * ks_] = vtr(vb + (16 * ks_) * VP + (db) * 64); dst[2 * ks_ + 1] = vtr(vb + (16 * ks_ + 8) * VP + (db) * 64); } } while (0)
            if (FOX) {
                const LAS float* bb = (const LAS float*)(buf + AT_B);
#pragma unroll
                for (int g = 0; g < 4; ++g) { const f32x4 b0 = *(const LAS f32x4*)(bb + 8 * g + 4 * hi), b1 = *(const LAS f32x4*)(bb + 32 + 8 * g + 4 * hi);
#pragma unroll
                    for (int j = 0; j < 4; ++j) { s0[4 * g + j] = s0[4 * g + j] * C2 + b0[j]; s1[4 * g + j] = s1[4 * g + j] * C2 + b1[j]; } }
                if (t == tmax_w) { const int qil = 32 * (w & 1) + r32;
#pragma unroll
                    for (int r = 0; r < 16; ++r) { const int j0 = crow(r, hi); if (j0 > qil) s0[r] = NEGBIG; if (j0 + 32 > qil) s1[r] = NEGBIG; } }
            } else {
                if (t == tmax_w) { const int il = qrow - 64 * t;
#pragma unroll
                    for (int r = 0; r < 16; ++r) { const int j0 = crow(r, hi), j1 = j0 + 32;
                        s0[r] = s0[r] * C2 + slope_l2 * (float)(j0 > il ? 2 * il - j0 : j0); s1[r] = s1[r] * C2 + slope_l2 * (float)(j1 > il ? 2 * il - j1 : j1); }
                } else {
#pragma unroll
                    for (int r = 0; r < 16; ++r) { const float cc = slope_l2 * (float)crow(r, 0); s0[r] = s0[r] * C2 + cc; s1[r] = s1[r] * C2 + cc; }
                    c32 = 32.f * slope_l2; hadd = hterm;
                }
            }
            float mx0 = s0[0], mx1 = s1[0];
#pragma unroll
            for (int r = 1; r < 16; ++r) { mx0 = fmaxf(mx0, s0[r]); mx1 = fmaxf(mx1, s1[r]); }
            float mx = fmaxf(mx0, mx1 + c32) + hadd;
            mx = half_max(mx) + base_t;
            const float mnew = fmaxf(mrun, mx), msub = mnew - base_t - hadd, msub1 = msub - c32;
            if (__any(mnew > mrun)) { const float alpha = __builtin_amdgcn_exp2f(mrun - mnew); lrun *= alpha;
#pragma unroll
                for (int db = 0; db < DV / 32; ++db)
#pragma unroll
                    for (int r = 0; r < 16; ++r) O[db][r] *= alpha; }
            mrun = mnew;
#define AT_RDH(dst, dp, kh) do { _Pragma("unroll") for (int d_ = 0; d_ < 2; ++d_) _Pragma("unroll") for (int k_ = 0; k_ < 2; ++k_) { \
                dst[d_ * 4 + k_ * 2] = vtr(vb + (16 * (2 * (kh) + k_)) * VP + (2 * (dp) + d_) * 64); dst[d_ * 4 + k_ * 2 + 1] = vtr(vb + (16 * (2 * (kh) + k_) + 8) * VP + (2 * (dp) + d_) * 64); } } while (0)
#define AT_PVH(cur, dp, kh) do { _Pragma("unroll") for (int d_ = 0; d_ < 2; ++d_) _Pragma("unroll") for (int k_ = 0; k_ < 2; ++k_) { \
                const s16x4 lo_ = cur[d_ * 4 + k_ * 2], hi_ = cur[d_ * 4 + k_ * 2 + 1]; \
                const bf16x8 vf_ = (bf16x8){lo_[0], lo_[1], lo_[2], lo_[3], hi_[0], hi_[1], hi_[2], hi_[3]}; \
                O[2 * (dp) + d_] = __builtin_amdgcn_mfma_f32_32x32x16_bf16(vf_, __builtin_bit_cast(bf16x8, pw[2 * (kh) + k_]), O[2 * (dp) + d_], 0, 0, 0); } } while (0)
            __builtin_amdgcn_sched_barrier(0);
            AT_RDH(vfa, 0, 0);
            __builtin_amdgcn_sched_barrier(0);
            float ps = 0.f; u32x4 pw[4];
#pragma unroll
            for (int r = 0; r < 16; ++r) { s0[r] = __builtin_amdgcn_exp2f(s0[r] - msub); ps += s0[r]; }
#pragma unroll
            for (int i = 0; i < 4; ++i) { pw[0][i] = pk2(s0[2 * i], s0[2 * i + 1]); pw[1][i] = pk2(s0[8 + 2 * i], s0[8 + 2 * i + 1]); }
            __builtin_amdgcn_sched_barrier(0);
            if constexpr (DV == 128) AT_RDH(vfb, 1, 0); else AT_RDH(vfb, 0, 1);
            __builtin_amdgcn_sched_barrier(0);
            AT_PVH(vfa, 0, 0);
            if constexpr (DV == 128) AT_PVH(vfb, 1, 0);
#pragma unroll
            for (int r = 0; r < 16; ++r) { s1[r] = __builtin_amdgcn_exp2f(s1[r] - msub1); ps += s1[r]; }
#pragma unroll
            for (int i = 0; i < 4; ++i) { pw[2][i] = pk2(s1[2 * i], s1[2 * i + 1]); pw[3][i] = pk2(s1[8 + 2 * i], s1[8 + 2 * i + 1]); }
#pragma unroll
            for (int i = 0; i < (DV == 128 ? 8 : 4); ++i) { __builtin_amdgcn_sched_group_barrier(0x008, 1, 0); __builtin_amdgcn_sched_group_barrier(0x402, (DV == 128 ? 7 : 14), 0); }
            __builtin_amdgcn_sched_barrier(0);
            if constexpr (DV == 128) {
                AT_RDH(vfa, 0, 1); AT_RDH(vfb, 1, 1); __builtin_amdgcn_sched_barrier(0);
                AT_PVH(vfa, 0, 1); AT_PVH(vfb, 1, 1);
            } else {
                AT_PVH(vfb, 0, 1);
            }
            lrun += ps;
            __builtin_amdgcn_sched_barrier(0);
#undef AT_PVH
#undef AT_RDH
#undef AT_RDV
        }
        }
        --t; ++it;
        { LAS unsigned char* buf = bufB;
        if (t <= tmax_w && !done) {
            const float bmax = FOX ? ((const LAS float*)(buf + AT_B))[63] : slope_l2 * (float)(64 * t + 63 - q0);
            if (__all(ubase + bmax < mrun)) done = true;
        }
        if (t <= tmax_w && !done) {
            const float base_t = FOX ? 0.f : slope_l2 * (float)(64 * t - q0); float c32 = 0.f, hadd = 0.f;
            f32x16 s0, s1;
#pragma unroll
            for (int r = 0; r < 16; ++r) { s0[r] = 0.f; s1[r] = 0.f; }
            const LAS unsigned char* kb = buf + AT_K + r32 * KP + hi * 16;
            const LAS unsigned char* vb = buf + AT_V + (4 * hi + ((lane & 15) >> 2)) * VP + (16 * ((lane >> 4) & 1) + 4 * (lane & 3)) * 2;
            bf16x8 kf[8];
#pragma unroll
            for (int d0 = 0; d0 < 4; ++d0) { kf[2 * d0] = *(const LAS bf16x8*)(kb + d0 * 32); kf[2 * d0 + 1] = *(const LAS bf16x8*)(kb + 32 * KP + d0 * 32); }
            __builtin_amdgcn_sched_barrier(0);
#pragma unroll
            for (int d0 = 0; d0 < 4; ++d0) {
                s0 = __builtin_amdgcn_mfma_f32_32x32x16_bf16(kf[2 * d0], qf[d0], s0, 0, 0, 0);
                s1 = __builtin_amdgcn_mfma_f32_32x32x16_bf16(kf[2 * d0 + 1], qf[d0], s1, 0, 0, 0);
            }
            s16x4 vfa[8], vfb[8];
#define AT_RDV(dst, db) do { _Pragma("unroll") for (int ks_ = 0; ks_ < 4; ++ks_) { dst[2 * ks_] = vtr(vb + (16 * ks_) * VP + (db) * 64); dst[2 * ks_ + 1] = vtr(vb + (16 * ks_ + 8) * VP + (db) * 64); } } while (0)
            if (FOX) {
                const LAS float* bb = (const LAS float*)(buf + AT_B);
#pragma unroll
                for (int g = 0; g < 4; ++g) { const f32x4 b0 = *(const LAS f32x4*)(bb + 8 * g + 4 * hi), b1 = *(const LAS f32x4*)(bb + 32 + 8 * g + 4 * hi);
#pragma unroll
                    for (int j = 0; j < 4; ++j) { s0[4 * g + j] = s0[4 * g + j] * C2 + b0[j]; s1[4 * g + j] = s1[4 * g + j] * C2 + b1[j]; } }
                if (t == tmax_w) { const int qil = 32 * (w & 1) + r32;
#pragma unroll
                    for (int r = 0; r < 16; ++r) { const int j0 = crow(r, hi); if (j0 > qil) s0[r] = NEGBIG; if (j0 + 32 > qil) s1[r] = NEGBIG; } }
            } else {
                if (t == tmax_w) { const int il = qrow - 64 * t;
#pragma unroll
                    for (int r = 0; r < 16; ++r) { const int j0 = crow(r, hi), j1 = j0 + 32;
                        s0[r] = s0[r] * C2 + slope_l2 * (float)(j0 > il ? 2 * il - j0 : j0); s1[r] = s1[r] * C2 + slope_l2 * (float)(j1 > il ? 2 * il - j1 : j1); }
                } else {
#pragma unroll
                    for (int r = 0; r < 16; ++r) { const float cc = slope_l2 * (float)crow(r, 0); s0[r] = s0[r] * C2 + cc; s1[r] = s1[r] * C2 + cc; }
                    c32 = 32.f * slope_l2; hadd = hterm;
                }
            }
            float mx0 = s0[0], mx1 = s1[0];
#pragma unroll
            for (int r = 1; r < 16; ++r) { mx0 = fmaxf(mx0, s0[r]); mx1 = fmaxf(mx1, s1[r]); }
            float mx = fmaxf(mx0, mx1 + c32) + hadd;
            mx = half_max(mx) + base_t;
            const float mnew = fmaxf(mrun, mx), msub = mnew - base_t - hadd, msub1 = msub - c32;
            if (__any(mnew > mrun)) { const float alpha = __builtin_amdgcn_exp2f(mrun - mnew); lrun *= alpha;
#pragma unroll
                for (int db = 0; db < DV / 32; ++db)
#pragma unroll
                    for (int r = 0; r < 16; ++r) O[db][r] *= alpha; }
            mrun = mnew;
#define AT_RDH(dst, dp, kh) do { _Pragma("unroll") for (int d_ = 0; d_ < 2; ++d_) _Pragma("unroll") for (int k_ = 0; k_ < 2; ++k_) { \
                dst[d_ * 4 + k_ * 2] = vtr(vb + (16 * (2 * (kh) + k_)) * VP + (2 * (dp) + d_) * 64); dst[d_ * 4 + k_ * 2 + 1] = vtr(vb + (16 * (2 * (kh) + k_) + 8) * VP + (2 * (dp) + d_) * 64); } } while (0)
#define AT_PVH(cur, dp, kh) do { _Pragma("unroll") for (int d_ = 0; d_ < 2; ++d_) _Pragma("unroll") for (int k_ = 0; k_ < 2; ++k_) { \
                const s16x4 lo_ = cur[d_ * 4 + k_ * 2], hi_ = cur[d_ * 4 + k_ * 2 + 1]; \
                const bf16x8 vf_ = (bf16x8){lo_[0], lo_[1], lo_[2], lo_[3], hi_[0], hi_[1], hi_[2], hi_[3]}; \
                O[2 * (dp) + d_] = __builtin_amdgcn_mfma_f32_32x32x16_bf16(vf_, __builtin_bit_cast(bf16x8, pw[2 * (kh) + k_]), O[2 * (dp) + d_], 0, 0, 0); } } while (0)
            __builtin_amdgcn_sched_barrier(0);
            AT_RDH(vfa, 0, 0);
            __builtin_amdgcn_sched_barrier(0);
            float ps = 0.f; u32x4 pw[4];
#pragma unroll
            for (int r = 0; r < 16; ++r) { s0[r] = __builtin_amdgcn_exp2f(s0[r] - msub); ps += s0[r]; }
#pragma unroll
            for (int i = 0; i < 4; ++i) { pw[0][i] = pk2(s0[2 * i], s0[2 * i + 1]); pw[1][i] = pk2(s0[8 + 2 * i], s0[8 + 2 * i + 1]); }
            __builtin_amdgcn_sched_barrier(0);
            if constexpr (DV == 128) AT_RDH(vfb, 1, 0); else AT_RDH(vfb, 0, 1);
            __builtin_amdgcn_sched_barrier(0);
            AT_PVH(vfa, 0, 0);
            if constexpr (DV == 128) AT_PVH(vfb, 1, 0);
#pragma unroll
            for (int r = 0; r < 16; ++r) { s1[r] = __builtin_amdgcn_exp2f(s1[r] - msub1); ps += s1[r]; }
#pragma unroll
            for (int i = 0; i < 4; ++i) { pw[2][i] = pk2(s1[2 * i], s1[2 * i + 1]); pw[3][i] = pk2(s1[8 + 2 * i], s1[8 + 2 * i + 1]); }
#pragma unroll
            for (int i = 0; i < (DV == 128 ? 8 : 4); ++i) { __builtin_amdgcn_sched_group_barrier(0x008, 1, 0); __builtin_amdgcn_sched_group_barrier(0x402, (DV == 128 ? 7 : 14), 0); }
            __builtin_amdgcn_sched_barrier(0);
            if constexpr (DV == 128) {
                AT_RDH(vfa, 0, 1); AT_RDH(vfb, 1, 1); __builtin_amdgcn_sched_barrier(0);
                AT_PVH(vfa, 0, 1); AT_PVH(vfb, 1, 1);
            } else {
                AT_PVH(vfb, 0, 1);
            }
            lrun += ps;
            __builtin_amdgcn_sched_barrier(0);
#undef AT_PVH
#undef AT_RDH
#undef AT_RDV
        }
        }
        if (lane == 0) flags[(pr & 1) * 8 + w] = done ? 1 : 0;
      }
      --t; ++it; if (t < 0) break;
    }
#undef AT_ISSUE
    __syncthreads();
    l_out = half_sum(lrun);
}

DI void fox_unit(const Args& a, LAS unsigned char* lds, int l, int b, int h, int qb) {
    const int tid = lt_tid(), lane = tid & 63, w = tid >> 6, r32 = lane & 31, hi = lane >> 5;
    const bf16_t* P = (const bf16_t*)(WSP(a) + WS_UP); bf16_t* CAT = (bf16_t*)(WSP(a) + WS_H);
    const size_t rowbase = (size_t)b * SEQ; const int q0 = qb * 256;
    f32x16 O[2]; float lt;
    const float sb = C2 * sqrtf(((const float*)(WSP(a) + WS_LAM))[80 + (l * 2 + b) * 12 + h]);
    attn_pass<64, true, 0>(lds, P, rowbase, q0, PC_QA + h * 64, PC_KA + h * 64, PC_VA + h * 64, (const float*)(WSP(a) + WS_CLOC), (const float*)(WSP(a) + WS_CTOT) + b * 64 * 4, h, sb, O, lt);
    const float inv = 1.f / lt;
    bf16_t* op = CAT + (rowbase + q0 + 32 * w + r32) * DM + h * 64;
#pragma unroll
    for (int db = 0; db < 2; ++db)
#pragma unroll
        for (int g = 0; g < 4; ++g) { u32x2 wv; wv.x = pk2(O[db][4 * g] * inv, O[db][4 * g + 1] * inv); wv.y = pk2(O[db][4 * g + 2] * inv, O[db][4 * g + 3] * inv);
            *(u32x2*)(op + db * 32 + 8 * g + 4 * hi) = wv; }
}
typedef _Float16 h16x4 __attribute__((ext_vector_type(4)));
DI void diff_pass_unit(const Args& a, LAS unsigned char* lds, int l, int b, int h, int qb, int pass) {
    const bf16_t* P = (const bf16_t*)(WSP(a) + WS_UP);
    const size_t rowbase = (size_t)b * SEQ; const int q0 = qb * 256;
    const float sb = C2 * sqrtf(((const float*)(WSP(a) + WS_LAM))[80 + (l * 2 + b) * 12 + 4 + h * 2 + pass]);
    f32x16 O[4]; float lt;
    const int qc = PC_QC + h * 128 + pass * 64, kc = PC_KC + h * 128 + pass * 64, vc = PC_VC + h * 128;
    if (h == 0) attn_pass<128, false, 0>(lds, P, rowbase, q0, qc, kc, vc, nullptr, nullptr, h, sb, O, lt);
    else if (h == 1) attn_pass<128, false, 1>(lds, P, rowbase, q0, qc, kc, vc, nullptr, nullptr, h, sb, O, lt);
    else if (h == 2) attn_pass<128, false, 2>(lds, P, rowbase, q0, qc, kc, vc, nullptr, nullptr, h, sb, O, lt);
    else attn_pass<128, false, 3>(lds, P, rowbase, q0, qc, kc, vc, nullptr, nullptr, h, sb, O, lt);
    const int tid = lt_tid(), lane = tid & 63, w = tid >> 6, r32 = lane & 31, hi = lane >> 5;
    const float inv = 1.f / lt;
    _Float16* op = (_Float16*)(WSP(a) + WS_OSCR) + ((size_t)pass * NTP + rowbase + q0 + 32 * w + r32) * 512 + h * 128;
#pragma unroll
    for (int db = 0; db < 4; ++db)
#pragma unroll
        for (int g = 0; g < 4; ++g) { h16x4 v; v[0] = (_Float16)(O[db][4 * g] * inv); v[1] = (_Float16)(O[db][4 * g + 1] * inv); v[2] = (_Float16)(O[db][4 * g + 2] * inv); v[3] = (_Float16)(O[db][4 * g + 3] * inv);
            *(h16x4*)(op + db * 32 + 8 * g + 4 * hi) = v; }
}
DI void phase_diff_combine(const Args& a, int l) {
    const int tid = lt_tid(), lane = tid & 63, wave = tid >> 6;
    const float lam = ((const float*)(WSP(a) + WS_LAM))[l]; const float omli = one_minus_lam_init(l);
    const _Float16* OS = (const _Float16*)(WSP(a) + WS_OSCR); bf16_t* CAT = (bf16_t*)(WSP(a) + WS_H);
    const float* gd = AIN(a, I_GDIFF) + l * 128 + (lane & 15) * 8;
    const f32x4 g0 = *(const f32x4*)gd, g1 = *(const f32x4*)(gd + 4);
    for (int m = blockIdx.x * 8 + wave; m < NTP; m += gridDim.x * 8) {
        const h16x4* p0 = (const h16x4*)(OS + (size_t)m * 512 + lane * 8); const h16x4* p1 = (const h16x4*)(OS + ((size_t)NTP + m) * 512 + lane * 8);
        const h16x4 a0 = p0[0], a1 = p0[1], b0 = p1[0], b1 = p1[1];
        float o[8]; float ss = 0.f;
#pragma unroll
        for (int j = 0; j < 4; ++j) { o[j] = (float)a0[j] - lam * (float)b0[j]; o[4 + j] = (float)a1[j] - lam * (float)b1[j]; }
#pragma unroll
        for (int j = 0; j < 8; ++j) ss += o[j] * o[j];
#pragma unroll
        for (int x = 1; x < 16; x <<= 1) ss += __shfl_xor(ss, x);
        const float rr = rsqrtf(ss * (1.f / 128.f) + EPS) * omli;
        u32x4 wv; wv.x = pk2(o[0] * rr * g0[0], o[1] * rr * g0[1]); wv.y = pk2(o[2] * rr * g0[2], o[3] * rr * g0[3]); wv.z = pk2(o[4] * rr * g1[0], o[5] * rr * g1[1]); wv.w = pk2(o[6] * rr * g1[2], o[7] * rr * g1[3]);
        *(u32x4*)(CAT + (size_t)m * DM + 512 + lane * 8) = wv;
    }
}
DI void kn_item(const Args& a, int l, int tile, int lane) {
    const bf16_t* P = (const bf16_t*)(WSP(a) + WS_UP); unsigned* KN = (unsigned*)(WSP(a) + WS_LAM) + 80 + (l * 2 + (tile >> 8)) * 12;
    const bf16_t* rp = P + (size_t)(tile * 64 + lane) * NPROJ;
#pragma unroll 4
    for (int hm = 0; hm < 12; ++hm) { const bf16_t* kp = rp + (hm < 4 ? PC_KA + hm * 64 : PC_KC + (hm - 4) * 64); float ss = 0.f;
#pragma unroll
        for (int i = 0; i < 8; ++i) { const u32x4 r = *(const u32x4*)(kp + 8 * i);
#pragma unroll
            for (int j = 0; j < 4; ++j) { const float x = __uint_as_float(r[j] << 16), y = __uint_as_float(r[j] & 0xffff0000u); ss += x * x + y * y; } }
        ss = wave_max(ss); if (lane == 0) atomicMax(KN + hm, __float_as_uint(ss)); }
}

DI void gla_local_item(const Args& a, LAS unsigned char* lds, int l, int b, int n) {
    lds = lnd(lds);
    const int tid = lt_tid();
    const bf16_t* P = (const bf16_t*)(WSP(a) + WS_UP); const float* PF = (const float*)(WSP(a) + WS_PF);
    LAS float* gb = (LAS float*)lds;
    LAS float* cb = gb + 64 * 16;
    LAS float* kl = cb + 64 * 128;
    LAS float* vv = kl + 64 * 128;
    const size_t m0 = (size_t)b * SEQ + 64 * n;
    { const int t = tid >> 3, c = (tid & 7) * 2; const float* p = PF + (m0 + t) * 32 + 4 + c; gb[t * 16 + c] = p[0]; gb[t * 16 + c + 1] = p[1]; }
#pragma unroll
    for (int i = 0; i < 2; ++i) { const int ch = tid + 512 * i, t = ch >> 4, c = (ch & 15) * 8; const u32x4 r = *(const u32x4*)(P + (m0 + t) * NPROJ + PC_KB + c);
#pragma unroll
        for (int j = 0; j < 4; ++j) { kl[t * 128 + c + 2 * j] = __uint_as_float(r[j] << 16); kl[t * 128 + c + 2 * j + 1] = __uint_as_float(r[j] & 0xffff0000u); } }
#pragma unroll
    for (int i = 0; i < 4; ++i) { const int ch = tid + 512 * i, t = ch >> 5, c = (ch & 31) * 8; const u32x4 r = *(const u32x4*)(P + (m0 + t) * NPROJ + PC_VB + c);
#pragma unroll
        for (int j = 0; j < 4; ++j) { vv[t * 256 + c + 2 * j] = __uint_as_float(r[j] << 16); vv[t * 256 + c + 2 * j + 1] = __uint_as_float(r[j] & 0xffff0000u); } }
    __syncthreads();
    { const int col = tid & 127, tq = tid >> 7; float W[16];
#pragma unroll
      for (int r = 0; r < 16; ++r) W[r] = AIN(a, I_WGU)[(l * 16 + r) * 128 + col];
      const float bu = AIN(a, I_BGU)[l * 128 + col];
      for (int t = tq * 16; t < tq * 16 + 16; ++t) { float z = bu;
#pragma unroll
          for (int r4 = 0; r4 < 4; ++r4) { const f32x4 gq = *(const LAS f32x4*)(gb + t * 16 + 4 * r4); z += (gq.x * W[4 * r4] + gq.y * W[4 * r4 + 1]) + (gq.z * W[4 * r4 + 2] + gq.w * W[4 * r4 + 3]); }
          cb[t * 128 + col] = logsig(z) * (1.f / 16.f); } }
    __syncthreads();
    { const int col = tid & 127, q = tid >> 7; float v[16]; float run = 0.f;
#pragma unroll
      for (int i = 0; i < 16; ++i) { run += cb[(q * 16 + i) * 128 + col]; v[i] = run; }
      gb[q * 128 + col] = run;
      __syncthreads();
      float off = 0.f;
#pragma unroll
      for (int qq = 0; qq < 3; ++qq) if (qq < q) off += gb[qq * 128 + col];
#pragma unroll
      for (int i = 0; i < 16; ++i) cb[(q * 16 + i) * 128 + col] = v[i] + off; }
    __syncthreads();
    { float* CB = (float*)(WSP(a) + WS_CB) + m0 * 128;
#pragma unroll
      for (int i = 0; i < 16; ++i) { const int e = tid + 512 * i, c = e & 127; const float cv = cb[e]; CB[e] = cv; kl[e] *= __expf(cb[63 * 128 + c] - cv); }
      if (tid < 128) ((float*)(WSP(a) + WS_GDEC))[((size_t)(b * 256 + n) * 4) * 32 + tid] = __expf(cb[63 * 128 + tid]); }
    __syncthreads();
    { const int h = tid >> 7, kh = (tid >> 6) & 1, v = tid & 63; float acc[16];
#pragma unroll
      for (int k = 0; k < 16; ++k) acc[k] = 0.f;
#pragma unroll 4
      for (int t = 0; t < 64; ++t) { const float vx = vv[t * 256 + h * 64 + v]; const LAS f32x4* kr = (const LAS f32x4*)(kl + t * 128 + h * 32 + kh * 16);
#pragma unroll
          for (int k4 = 0; k4 < 4; ++k4) { const f32x4 kq = kr[k4]; acc[4 * k4] += kq.x * vx; acc[4 * k4 + 1] += kq.y * vx; acc[4 * k4 + 2] += kq.z * vx; acc[4 * k4 + 3] += kq.w * vx; } }
      float* U = (float*)(WSP(a) + WS_GU) + ((size_t)((b * 256 + n) * 4 + h) * 32 + kh * 16) * 64 + v;
#pragma unroll
      for (int k = 0; k < 16; ++k) U[k * 64] = acc[k]; }
    __syncthreads();
}
DI void gla_scan_item(const Args& a, int l, int item) {
    const int tid = lt_tid(), b = item >> 4, h = (item >> 2) & 3, e = (item & 3) * 512 + tid, k = e >> 6;
    const float* U = (const float*)(WSP(a) + WS_GU); const float* DEC = (const float*)(WSP(a) + WS_GDEC); float* GS = (float*)(WSP(a) + WS_GS);
    float S = 0.f;
#pragma unroll 32
    for (int n = 0; n < 256; ++n) { const size_t ch = (size_t)(b * 256 + n) * 4 + h; GS[ch * 2048 + e] = S; S = DEC[ch * 32 + k] * S + U[ch * 2048 + e]; }
    OUTP(a)[O_GSP + (size_t)((l * 2 + b) * 4 + h) * 2048 + e] = S;
}
DI void gla_out_item(const Args& a, LAS unsigned char* lds, int l, int b, int n, int h) {
    lds = lnd(lds);
    const int tid = lt_tid(), lane = tid & 63, wv = tid >> 6;
    const bf16_t* P = (const bf16_t*)(WSP(a) + WS_UP); bf16_t* CAT = (bf16_t*)(WSP(a) + WS_H);
    LAS float* qe = (LAS float*)lds;
    LAS float* ke = qe + 64 * 36;
    LAS float* vv = ke + 64 * 36;
    LAS float* Ss = vv + 64 * 64;
    LAS float* A = Ss + 32 * 64;
    LAS float* rb = A + 64 * 68;
    const size_t m0 = (size_t)b * SEQ + 64 * n;
    { const int half = tid >> 8, c = tid & 255, t = c >> 2, k0 = (c & 3) * 8;
      const u32x4 r = *(const u32x4*)(P + (m0 + t) * NPROJ + (half ? PC_KB : PC_QB) + h * 32 + k0);
      const float* cp = (const float*)(WSP(a) + WS_CB) + (m0 + t) * 128 + h * 32 + k0; const f32x4 c0 = *(const f32x4*)cp, c1 = *(const f32x4*)(cp + 4);
      LAS float* dst = (half ? ke : qe) + t * 36 + k0;
#pragma unroll
      for (int j = 0; j < 4; ++j) { const float x0 = __uint_as_float(r[j] << 16), x1 = __uint_as_float(r[j] & 0xffff0000u); const float ca = (j < 2 ? c0[2 * j] : c1[2 * j - 4]), cb1 = (j < 2 ? c0[2 * j + 1] : c1[2 * j - 3]);
          dst[2 * j] = half ? x0 * __expf(-ca) : x0 * 0.17677669529663687f * __expf(ca); dst[2 * j + 1] = half ? x1 * __expf(-cb1) : x1 * 0.17677669529663687f * __expf(cb1); } }
    { const int t = tid >> 3, c = (tid & 7) * 8; const u32x4 r = *(const u32x4*)(P + (m0 + t) * NPROJ + PC_VB + h * 64 + c), r2 = *(const u32x4*)(P + (m0 + t) * NPROJ + PC_RB + h * 64 + c);
#pragma unroll
      for (int j = 0; j < 4; ++j) { vv[t * 64 + c + 2 * j] = __uint_as_float(r[j] << 16); vv[t * 64 + c + 2 * j + 1] = __uint_as_float(r[j] & 0xffff0000u);
          rb[t * 64 + c + 2 * j] = silu_f(__uint_as_float(r2[j] << 16)); rb[t * 64 + c + 2 * j + 1] = silu_f(__uint_as_float(r2[j] & 0xffff0000u)); } }
    { const float* GS = (const float*)(WSP(a) + WS_GS) + ((size_t)(b * 256 + n) * 4 + h) * 2048; *(LAS f32x4*)(Ss + tid * 4) = *(const f32x4*)(GS + tid * 4); }
    __syncthreads();
    { float acc[8];
#pragma unroll
      for (int i = 0; i < 8; ++i) acc[i] = 0.f;
#pragma unroll
      for (int k4 = 0; k4 < 8; ++k4) { const f32x4 kv = *(const LAS f32x4*)(ke + lane * 36 + 4 * k4);
#pragma unroll
          for (int i = 0; i < 8; ++i) { const f32x4 qv = *(const LAS f32x4*)(qe + (wv + 8 * i) * 36 + 4 * k4); acc[i] += (qv.x * kv.x + qv.y * kv.y) + (qv.z * kv.z + qv.w * kv.w); } }
#pragma unroll
      for (int i = 0; i < 8; ++i) A[(wv + 8 * i) * 68 + lane] = (lane <= wv + 8 * i) ? acc[i] : 0.f; }
    __syncthreads();
    float o[8];
#pragma unroll
    for (int i = 0; i < 8; ++i) o[i] = 0.f;
#pragma unroll 4
    for (int m4 = 0; m4 < 16; ++m4) { const float v0 = vv[(4 * m4) * 64 + lane], v1 = vv[(4 * m4 + 1) * 64 + lane], v2 = vv[(4 * m4 + 2) * 64 + lane], v3 = vv[(4 * m4 + 3) * 64 + lane];
#pragma unroll
        for (int i = 0; i < 8; ++i) { const f32x4 av = *(const LAS f32x4*)(A + (wv + 8 * i) * 68 + 4 * m4); o[i] += (av.x * v0 + av.y * v1) + (av.z * v2 + av.w * v3); } }
#pragma unroll 4
    for (int k4 = 0; k4 < 8; ++k4) { const float s0 = Ss[(4 * k4) * 64 + lane], s1 = Ss[(4 * k4 + 1) * 64 + lane], s2 = Ss[(4 * k4 + 2) * 64 + lane], s3 = Ss[(4 * k4 + 3) * 64 + lane];
#pragma unroll
        for (int i = 0; i < 8; ++i) { const f32x4 qv = *(const LAS f32x4*)(qe + (wv + 8 * i) * 36 + 4 * k4); o[i] += (qv.x * s0 + qv.y * s1) + (qv.z * s2 + qv.w * s3); } }
    const float gg = AIN(a, I_GGLA)[l * 64 + lane];
#pragma unroll
    for (int i = 0; i < 8; ++i) { const int t = wv + 8 * i; const float rr = rsqrtf(wave_sum(o[i] * o[i]) * (1.f / 64.f) + EPS);
        CAT[(m0 + t) * DM + 256 + h * 64 + lane] = (bf16_t)(pk2(o[i] * rr * gg * rb[t * 64 + lane], 0.f) & 0xffffu); }
    __syncthreads();
}

DI void logf_item(const Args& a, int l, int tile, int h, int lane) {
    const float* PF = (const float*)(WSP(a) + WS_PF); const float bf = AIN(a, I_BF)[l * 4 + h];
    const int m0 = tile * 256 + 4 * lane; float lf[4];
#pragma unroll
    for (int i = 0; i < 4; ++i) lf[i] = logsig(PF[(size_t)(m0 + i) * 32 + h] + bf);
    if (tile == 128) {
#pragma unroll
        for (int i = 0; i < 4; ++i) OUTP(a)[O_FLS + ((size_t)l * NTS + (m0 + i - NTP)) * 4 + h] = lf[i];
        return; }
#pragma unroll
    for (int i = 0; i < 4; ++i) OUTP(a)[O_FLP + ((size_t)l * NTP + m0 + i) * 4 + h] = lf[i];
    lf[1] += lf[0]; lf[2] += lf[1]; lf[3] += lf[2];
    float inc = lf[3];
#pragma unroll
    for (int o = 1; o < 64; o <<= 1) { const float v = __shfl_up(inc, o); if (lane >= o) inc += v; }
    const float excl = inc - lf[3];
    float* CL = (float*)(WSP(a) + WS_CLOC);
#pragma unroll
    for (int i = 0; i < 4; ++i) CL[(size_t)(m0 + i) * 4 + h] = excl + lf[i];
    if (lane == 63) ((float*)(WSP(a) + WS_CTOT))[tile * 4 + h] = inc;
}

#define MINI_IN_GEMM 1
constexpr int NKS = 1040;
DI void samp_softmax(LAS float* S, LAS float* linv, int tid) {
    const int lane = tid & 63, wv = tid >> 6;
#pragma unroll
    for (int rr = 0; rr < 2; ++rr) { LAS float* row = S + (2 * wv + rr) * NKS; float mx = NEGBIG;
        for (int j = lane; j < NKS; j += 64) mx = fmaxf(mx, row[j]);
        mx = wave_max(mx); float sm = 0.f;
        for (int j = lane; j < NKS; j += 64) { const float p = __expf(row[j] - mx); row[j] = p; sm += p; }
        sm = wave_sum(sm); if (lane == 0) linv[2 * wv + rr] = 1.f / sm; }
}
template <bool FOX>
DI void samp_scores(LAS float* S, const LAS float* qs, const LAS float* caux, const float* kc, const float* kn, int KW, float slope, int tid) {
    const float cref = FOX ? caux[NKS - 1] : 0.f;
    for (int j = tid; j < NKS; j += 512) {
        const float* kr = j < 1024 ? kc + (size_t)j * KW : kn + (size_t)(j - 1024) * KW;
        f32x4 kv[16];
#pragma unroll
        for (int i = 0; i < 16; ++i) kv[i] = *(const f32x4*)(kr + 4 * i);
        const float bj = FOX ? cref - caux[j] : 0.f;
#pragma unroll 4
        for (int qi = 0; qi < 16; ++qi) { float d = 0.f;
#pragma unroll
            for (int i = 0; i < 16; ++i) { const f32x4 q = *(const LAS f32x4*)(qs + qi * 64 + 4 * i); d += (q.x * kv[i].x + q.y * kv[i].y) + (q.z * kv[i].z + q.w * kv[i].w); }
            float s = d * 0.125f;
            if (FOX) { s += bj; if (j > 1024 + qi) s = NEGBIG; } else s -= slope * fabsf((float)(1024 + qi - j));
            S[qi * NKS + j] = s; }
    }
}
DI void fox_sample_item(const Args& a, LAS unsigned char* lds, int l, int b, int h) {
    lds = lnd(lds);
    const int tid = lt_tid(), lane = tid & 63;
    const bf16_t* P = (const bf16_t*)(WSP(a) + WS_UP); bf16_t* CAT = (bf16_t*)(WSP(a) + WS_H);
    LAS float* S = (LAS float*)lds; LAS float* qs = S + 16 * NKS; LAS float* caux = qs + 16 * 64; LAS float* linv = caux + NKS + 8;
    const int m0 = NTP + b * 16; const size_t lb = (size_t)l * 16 + b;
    for (int e = tid; e < 1024; e += 512) qs[e] = bf2f(P[(size_t)(m0 + (e >> 6)) * NPROJ + PC_QA + h * 64 + (e & 63)]);
    if (tid < 64) { const float* cl = AIN(a, I_CFL) + (lb * 1024 + 16 * lane) * 4 + h; float v[16]; float run = 0.f;
#pragma unroll
        for (int i = 0; i < 16; ++i) { run += cl[i * 4]; v[i] = run; }
        float inc = run;
#pragma unroll
        for (int o = 1; o < 64; o <<= 1) { const float t = __shfl_up(inc, o); if (lane >= o) inc += t; }
        const float ex = inc - run;
#pragma unroll
        for (int i = 0; i < 16; ++i) caux[16 * lane + i] = ex + v[i]; }
    __syncthreads();
    if (tid == 0) { float run = caux[1023]; for (int t = 0; t < 16; ++t) { run += OUTP(a)[O_FLS + (lb * 16 + t) * 4 + h]; caux[1024 + t] = run; } }
    __syncthreads();
    samp_scores<true>(S, qs, caux, AIN(a, I_CFK) + (lb * 1024 * 4 + h) * 64, OUTP(a) + O_FKS + (lb * 16 * 4 + h) * 64, 256, 0.f, tid);
    __syncthreads();
    samp_softmax(S, linv, tid);
    __syncthreads();
    {
      const int wv = tid >> 6; LAS float* red = (LAS float*)(lds + 80000);
      const float* vc = AIN(a, I_CFV) + (lb * 1024 * 4 + h) * 64 + lane; const float* vn = OUTP(a) + O_FVS + (lb * 16 * 4 + h) * 64 + lane;
      float acc[16];
#pragma unroll
      for (int i = 0; i < 16; ++i) acc[i] = 0.f;
#pragma unroll 5
      for (int jj = 0; jj < 130; ++jj) { const int j = 130 * wv + jj; const float v = j < 1024 ? vc[(size_t)j * 256] : vn[(size_t)(j - 1024) * 256];
#pragma unroll
          for (int i = 0; i < 16; ++i) acc[i] += S[i * NKS + j] * v; }
#pragma unroll
      for (int i = 0; i < 16; ++i) red[(wv * 16 + i) * 64 + lane] = acc[i];
      __syncthreads();
      const int d = tid & 63, qg = tid >> 6;
#pragma unroll
      for (int r = 0; r < 2; ++r) { const int qi = 2 * qg + r; float sum = 0.f;
#pragma unroll
          for (int x = 0; x < 8; ++x) sum += red[(x * 16 + qi) * 64 + d];
          CAT[(size_t)(m0 + qi) * DM + h * 64 + d] = (bf16_t)(pk2(sum * linv[qi], 0.f) & 0xffffu); } }
    __syncthreads();
}
DI void diff_sample_item(const Args& a, LAS unsigned char* lds, int l, int b, int h) {
    lds = lnd(lds);
    const int tid = lt_tid(), lane = tid & 63, wv = tid >> 6;
    const bf16_t* P = (const bf16_t*)(WSP(a) + WS_UP); bf16_t* CAT = (bf16_t*)(WSP(a) + WS_H);
    LAS float* S = (LAS float*)lds; LAS float* qs = S + 16 * NKS; LAS float* caux = qs + 16 * 64; LAS float* linv = caux + NKS + 8; LAS float* red = linv + 16;
    const int m0 = NTP + b * 16; const size_t lb = (size_t)l * 16 + b;
    const float slope = exp2f(-2.f * (float)(h + 1)), lam = ((const float*)(WSP(a) + WS_LAM))[l]; const float omli = one_minus_lam_init(l);
    const int d = tid & 127, qg = tid >> 7;
    float o[4] = {0.f, 0.f, 0.f, 0.f};
    for (int mp = 0; mp < 2; ++mp) {
        for (int e = tid; e < 1024; e += 512) qs[e] = bf2f(P[(size_t)(m0 + (e >> 6)) * NPROJ + PC_QC + h * 128 + mp * 64 + (e & 63)]);
        __syncthreads();
        samp_scores<false>(S, qs, caux, AIN(a, I_CDK) + (lb * 1024 * 4 + h) * 128 + mp * 64, OUTP(a) + O_DKS + (lb * 16 * 4 + h) * 128 + mp * 64, 512, slope, tid);
        __syncthreads();
        samp_softmax(S, linv, tid);
        __syncthreads();
        { LAS float* redv = (LAS float*)(lds + 80000);
          const float* vc = AIN(a, I_CDV) + (lb * 1024 * 4 + h) * 128 + lane; const float* vn = OUTP(a) + O_DVS + (lb * 16 * 4 + h) * 128 + lane;
          float acc0[16], acc1[16];
#pragma unroll
          for (int i = 0; i < 16; ++i) { acc0[i] = 0.f; acc1[i] = 0.f; }
#pragma unroll 5
          for (int jj = 0; jj < 130; ++jj) { const int j = 130 * wv + jj; const float* vp = j < 1024 ? vc + (size_t)j * 512 : vn + (size_t)(j - 1024) * 512; const float v0 = vp[0], v1 = vp[64];
#pragma unroll
              for (int i = 0; i < 16; ++i) { const float p = S[i * NKS + j]; acc0[i] += p * v0; acc1[i] += p * v1; } }
#pragma unroll
          for (int i = 0; i < 16; ++i) { redv[(wv * 16 + i) * 128 + lane] = acc0[i]; redv[(wv * 16 + i) * 128 + 64 + lane] = acc1[i]; }
          __syncthreads();
#pragma unroll
          for (int i = 0; i < 4; ++i) { float sum = 0.f;
#pragma unroll
              for (int x = 0; x < 8; ++x) sum += redv[(x * 16 + 4 * qg + i) * 128 + d];
              const float v = sum * linv[4 * qg + i]; o[i] = (mp == 0) ? v : o[i] - lam * v; } }
        __syncthreads();
    }
#pragma unroll
    for (int i = 0; i < 4; ++i) { const float s = wave_sum(o[i] * o[i]); if (lane == 0) red[wv * 4 + i] = s; }
    __syncthreads();
    const float gd = AIN(a, I_GDIFF)[l * 128 + d] * omli;
#pragma unroll
    for (int i = 0; i < 4; ++i) { const float tot = red[(2 * qg) * 4 + i] + red[(2 * qg + 1) * 4 + i]; const float rr = rsqrtf(tot * (1.f / 128.f) + EPS);
        CAT[(size_t)(m0 + 4 * qg + i) * DM + 512 + h * 128 + d] = (bf16_t)(pk2(o[i] * rr * gd, 0.f) & 0xffffu); }
    __syncthreads();
}
DI void gla_sample_item(const Args& a, int l, int b, int h, int lane) {
    const bf16_t* P = (const bf16_t*)(WSP(a) + WS_UP); bf16_t* CAT = (bf16_t*)(WSP(a) + WS_H); const float* PF = (const float*)(WSP(a) + WS_PF);
    const size_t sb = (((size_t)l * 16 + b) * 4 + h) * 2048;
    float S[32];
#pragma unroll
    for (int k = 0; k < 32; ++k) S[k] = AIN(a, I_SG)[sb + k * 64 + lane];
    const int kk = lane & 31; float W[16];
#pragma unroll
    for (int r = 0; r < 16; ++r) W[r] = AIN(a, I_WGU)[(l * 16 + r) * 128 + h * 32 + kk];
    const float bu = AIN(a, I_BGU)[l * 128 + h * 32 + kk], gg = AIN(a, I_GGLA)[l * 64 + lane];
    for (int t = 0; t < 16; ++t) { const size_t m = NTP + b * 16 + t;
        float z = bu;
#pragma unroll
        for (int r = 0; r < 16; ++r) z += PF[m * 32 + 4 + r] * W[r];
        const float av = __expf(logsig(z) * (1.f / 16.f));
        const float qv = bf2f(P[m * NPROJ + PC_QB + h * 32 + kk]) * 0.17677669529663687f, kv = bf2f(P[m * NPROJ + PC_KB + h * 32 + kk]);
        const float vx = bf2f(P[m * NPROJ + PC_VB + h * 64 + lane]);
        float o = 0.f;
#pragma unroll
        for (int k = 0; k < 32; ++k) { const float ak = __shfl(av, k), kx = __shfl(kv, k), qx = __shfl(qv, k); S[k] = ak * S[k] + kx * vx; o += qx * S[k]; }
        const float rr = rsqrtf(wave_sum(o * o) * (1.f / 64.f) + EPS);
        const float rb = bf2f(P[m * NPROJ + PC_RB + h * 64 + lane]);
        CAT[m * DM + 256 + h * 64 + lane] = (bf16_t)(pk2(o * rr * gg * silu_f(rb), 0.f) & 0xffffu); }
#pragma unroll
    for (int k = 0; k < 32; ++k) OUTP(a)[O_GSS + sb + k * 64 + lane] = S[k];
}


DI void mini_tile(const bf16_t* __restrict__ A, int lda, const bf16_t* __restrict__ Bt, int ldb, int row0, int brow0, int k0, int ksteps, f32x16& acc, int r32, int hi) {
    const bf16_t* ap = A + (size_t)(row0 + r32) * lda + k0 + 8 * hi; const bf16_t* bp = Bt + (size_t)(brow0 + r32) * ldb + k0 + 8 * hi;
#pragma unroll 8
    for (int s = 0; s < ksteps; ++s) { const bf16x8 av = *(const bf16x8*)(ap + 16 * s), bv = *(const bf16x8*)(bp + 16 * s); acc = __builtin_amdgcn_mfma_f32_32x32x16_bf16(bv, av, acc, 0, 0, 0); }
}
DI void mini_swiglu(const Args& a, int l, int i) {
    const int tid = lt_tid(), lane = tid & 63, wave = tid >> 6, r32 = lane & 31, hi = lane >> 5;
    const bf16_t* H = (const bf16_t*)(WSP(a) + WS_H); const bf16_t* W = (const bf16_t*)(WSP(a) + WS_WFI + (size_t)(l * 2 + i) * SZ_WFI1); bf16_t* U = (bf16_t*)(WSP(a) + WS_UP);
    for (int it = blockIdx.x * 8 + wave; it < 8 * 88; it += gridDim.x * 8) { const int mt = it / 88, g = it % 88, brow = 256 * (g >> 2) + 32 * (g & 3);
        f32x16 ag, au;
#pragma unroll
        for (int r = 0; r < 16; ++r) { ag[r] = 0.f; au[r] = 0.f; }
        const bf16_t* ap = H + (size_t)(NTP + 32 * mt + r32) * DM + 8 * hi; const bf16_t* bg = W + (size_t)(brow + r32) * DM + 8 * hi; const bf16_t* bu = bg + (size_t)128 * DM;
#pragma unroll 4
        for (int s = 0; s < 64; ++s) { const bf16x8 av = *(const bf16x8*)(ap + 16 * s), g8 = *(const bf16x8*)(bg + 16 * s), u8 = *(const bf16x8*)(bu + 16 * s);
            ag = __builtin_amdgcn_mfma_f32_32x32x16_bf16(g8, av, ag, 0, 0, 0); au = __builtin_amdgcn_mfma_f32_32x32x16_bf16(u8, av, au, 0, 0, 0); }
        bf16_t* up = U + (size_t)(NTP + 32 * mt + r32) * DFF + 32 * g + 4 * hi;
#pragma unroll
        for (int q = 0; q < 4; ++q) { u32x2 w; w.x = pk2(silu_f(ag[4 * q]) * au[4 * q], silu_f(ag[4 * q + 1]) * au[4 * q + 1]); w.y = pk2(silu_f(ag[4 * q + 2]) * au[4 * q + 2], silu_f(ag[4 * q + 3]) * au[4 * q + 3]); *(u32x2*)(up + 8 * q) = w; }
    }
}
DI void mini_f32(const Args& a, const bf16_t* A, int lda, const bf16_t* Bt, int K) {
    const int tid = lt_tid(), lane = tid & 63, wave = tid >> 6, r32 = lane & 31, hi = lane >> 5;
    float* YS = (float*)(WSP(a) + WS_YS); const int kc = K / 8;
    for (int it = blockIdx.x * 8 + wave; it < 2048; it += gridDim.x * 8) { const int ks = it & 7, nt = (it >> 3) & 31, mt = it >> 8;
        f32x16 acc;
#pragma unroll
        for (int r = 0; r < 16; ++r) acc[r] = 0.f;
        mini_tile(A, lda, Bt, K, NTP + 32 * mt, 32 * nt, ks * kc, kc / 16, acc, r32, hi);
        float* yp = YS + ((size_t)ks * NTS + 32 * mt + r32) * DM + 32 * nt + 4 * hi;
#pragma unroll
        for (int q = 0; q < 4; ++q) *(f32x4*)(yp + 8 * q) = (f32x4){acc[4 * q], acc[4 * q + 1], acc[4 * q + 2], acc[4 * q + 3]};
    }
}
DI void mini_proj(const Args& a, int l) {
    const int tid = lt_tid(), lane = tid & 63, wave = tid >> 6, r32 = lane & 31, hi = lane >> 5;
    const bf16_t* H = (const bf16_t*)(WSP(a) + WS_H); const bf16_t* W = (const bf16_t*)(WSP(a) + WS_WIN + (size_t)l * SZ_WIN1); bf16_t* P = (bf16_t*)(WSP(a) + WS_UP); float* PF = (float*)(WSP(a) + WS_PF);
    for (int it = blockIdx.x * 8 + wave; it < 8 * 97; it += gridDim.x * 8) { const int mt = it / 97, g = it % 97;
        f32x16 acc;
#pragma unroll
        for (int r = 0; r < 16; ++r) acc[r] = 0.f;
        mini_tile(H, DM, W, DM, NTP + 32 * mt, 32 * g, 0, 64, acc, r32, hi);
        const int rs = 32 * mt + r32, c0 = 32 * g + 4 * hi;
        bf16_t* pp = P + (size_t)(NTP + rs) * NPROJ + c0;
        float* dst = nullptr;
        if (g >= 8 && g < 16) dst = OUTP(a) + O_FKS + ((size_t)l * NTS + rs) * 256 + (c0 - 256);
        else if (g >= 16 && g < 24) dst = OUTP(a) + O_FVS + ((size_t)l * NTS + rs) * 256 + (c0 - 512);
        else if (g >= 64 && g < 80) dst = OUTP(a) + O_DKS + ((size_t)l * NTS + rs) * 512 + (c0 - 2048);
        else if (g >= 80 && g < 96) dst = OUTP(a) + O_DVS + ((size_t)l * NTS + rs) * 512 + (c0 - 2560);
        else if (g == 96) dst = PF + (size_t)(NTP + rs) * 32 + 4 * hi;
#pragma unroll
        for (int q = 0; q < 4; ++q) { u32x2 w; w.x = pk2(acc[4 * q], acc[4 * q + 1]); w.y = pk2(acc[4 * q + 2], acc[4 * q + 3]); *(u32x2*)(pp + 8 * q) = w;
            if (dst) *(f32x4*)(dst + 8 * q) = (f32x4){acc[4 * q], acc[4 * q + 1], acc[4 * q + 2], acc[4 * q + 3]}; }
    }
}

constexpr int N_PHASES = 32;
#ifndef PHM
#define PHM 0xffff
#endif
#define EN(b) ((PHM >> (b)) & 1)
__global__ void __launch_bounds__(512, 2) hybrid_fwd(Args a) {
    LAS unsigned char* lds_base = (LAS unsigned char*)lds_raw;
    { const unsigned hw = (unsigned)__builtin_amdgcn_s_getreg((5 << 11) | 4) & 63u;
      if ((threadIdx.x & 63) == 0) lds_base[LDS_WTAB + hw] = (unsigned char)(threadIdx.x >> 6);
      if (threadIdx.x < 2) ((LAS unsigned*)(lds_base + LDS_XBST))[threadIdx.x] = 0u;
      __syncthreads(); }
    (void)xcd_barrier_post((unsigned*)(WSP(a) + WS_BAR), (volatile LAS unsigned*)(lds_base + LDS_XBST));
    for (int pi = 0; pi < a.nph; ++pi) {
      { int pj = pi; asm volatile("" : "+s"(pj)); const int ph = a.plist[pj];
        unsigned char* ws = WSP(a);
        LAS unsigned char* lds = lnd(lds_base);
        if (ph == 0) { if (EN(0)) phase_prologue(a, lds); }
        else if (ph == 1) { if (EN(1)) phase_rows(a, 0, -1, 0.f, 0, 0, true); }
        else if (ph >= 100) { }
        else {
            const int l = (ph - 2) / 15, kp = (ph - 2) % 15;
            const int k = kp == 0 ? 0 : kp == 2 ? 1 : kp == 3 ? 2 : kp == 4 ? 3 : kp == 5 ? 4 : kp == 6 ? 5 : kp == 7 ? 6 : kp == 9 ? 7 : kp == 10 ? 8 : kp == 11 ? 9 : kp == 13 ? 10 : kp == 14 ? 11 : -1;
            if (kp == 1 || kp == 12) mini_f32(a, (const bf16_t*)(ws + WS_UP), DFF, (const bf16_t*)(ws + WS_WFO + (size_t)(l * 2 + (kp == 12)) * SZ_WFO1), DFF);
            else if (kp == 8) { phase_diff_combine(a, l); mini_f32(a, (const bf16_t*)(ws + WS_H), DM, (const bf16_t*)(ws + WS_WOUT + (size_t)l * SZ_WOUT1), DM); }
            else if (k == 0 || k == 9) { if (EN(2)) {
                const int i = (k == 9);
                pg8::Gemm g{(const bf16_t*)(ws + WS_H), (const bf16_t*)(ws + WS_WFI + (size_t)(l * 2 + i) * SZ_WFI1), MTOT, 2 * DFF, DM};
                pg8::StaticOrder S; S.init(MTOT, 2 * DFF, gridDim.x, blockIdx.x);
                EpiSwiglu E{(bf16_t*)(ws + WS_UP)};
                pg8::gemm_phase<EpiSwiglu, pg8::StaticOrder, true, true>(lds, g, S, E); }
            } else if (k == 1 || k == 10 || k == 7) { if (EN(3)) {
                const int i = (k == 10);
                pg8::Gemm g{k == 7 ? (const bf16_t*)(ws + WS_H) : (const bf16_t*)(ws + WS_UP),
                            k == 7 ? (const bf16_t*)(ws + WS_WOUT + (size_t)l * SZ_WOUT1) : (const bf16_t*)(ws + WS_WFO + (size_t)(l * 2 + i) * SZ_WFO1), NTP, DM, k == 7 ? DM : DFF};
                pg8::StaticOrder S; S.init(NTP, DM, gridDim.x, blockIdx.x);
                EpiF32 E{(bf16_t*)(ws + WS_Y)};
                pg8::gemm_phase<EpiF32, pg8::StaticOrder, true, true>(lds, g, S, E);
#ifdef MINI_IN_GEMM
                if (k != 7) mini_f32(a, (const bf16_t*)(WSP(a) + WS_UP), DFF, (const bf16_t*)(WSP(a) + WS_WFO + (size_t)(l * 2 + i) * SZ_WFO1), DFF);
#endif
                }
            } else if (k == 3) { if (EN(4)) {
                pg8::Gemm g{(const bf16_t*)(ws + WS_H), (const bf16_t*)(ws + WS_WIN + (size_t)l * SZ_WIN1), MTOT, NPROJ, DM};
                pg8::StaticOrder S; S.init(MTOT, NPROJ, gridDim.x, blockIdx.x);
                EpiProj E{(bf16_t*)(ws + WS_UP), OUTP(a), (float*)(ws + WS_PF), l};
                pg8::gemm_phase<EpiProj, pg8::StaticOrder, true, true>(lds, g, S, E); }
            } else if (k == 2) { if (EN(1)) phase_rows(a, l, 0, 0.5f, 1, l, l == 0); }
            else if (k == 8) { if (EN(1)) phase_rows(a, l, 1, 1.0f, 2, l, false); }
            else if (k == 11) { if (EN(1)) phase_rows(a, l, 2, 0.5f, l == 0 ? 0 : -1, 1, false); }
            else if (k == 4) { if (EN(5)) { const int tid = lt_tid(), lane = tid & 63, wave = tid >> 6;
                for (int it = wave * gridDim.x + blockIdx.x; it < 516 + 512; it += gridDim.x * 8) { if (it < 516) logf_item(a, l, it >> 2, it & 3, lane); else kn_item(a, l, it - 516, lane); }
                for (int it = blockIdx.x; it < 512; it += gridDim.x) gla_local_item(a, lds, l, it >> 8, it & 255); }
            } else if (k == 5) { const int tid = lt_tid(), lane = tid & 63, wave = tid >> 6;
                for (int it = blockIdx.x; it < 40; it += gridDim.x) {
                    if (it < 32) gla_scan_item(a, l, it);
                    else { const int wi = (it - 32) * 8 + wave; gla_sample_item(a, l, wi >> 2, wi & 3, lane); }
                }
            } else if (k == 6) {
                const int tid = lt_tid();
                LAS int* qslot = (LAS int*)(lds + LDS_BYTES - 16); unsigned* ctr = (unsigned*)(ws + WS_LAM) + 16 + pi;
                for (;;) {
                    __syncthreads();
                    if (tid == 0) qslot[0] = (int)atomicAdd(ctr, 1u);
                    __syncthreads();
                    const int it = qslot[0];
                    if (it >= 2176) break;
                    if (it >= 256 && it < 320) fox_sample_item(a, lds, l, (it - 256) >> 2, (it - 256) & 3);
                    else if (it >= 320 && it < 384) diff_sample_item(a, lds, l, (it - 320) >> 2, (it - 320) & 3);
                    else if (it < 1152) { const int j = it < 256 ? it : it - 128, rem = j & 255; diff_pass_unit(a, lds, l, (rem >> 1) & 1, 3 - (j >> 8), 63 - (rem >> 2), rem & 1);
#ifdef PROBE_DIFF2
                        diff_pass_unit(a, lds, l, (rem >> 1) & 1, 3 - (j >> 8), 63 - (rem >> 2), rem & 1);
#endif
                    }
                    else if (it < 1664) { const int j = it - 1152; fox_unit(a, lds, l, j >> 8, (j >> 6) & 3, 63 - (j & 63)); }
                    else { const int j = (it - 1664) * 4;
                        for (int hh = 0; hh < 4; ++hh) gla_out_item(a, lds, l, j >> 10, (j >> 2) & 255, hh);
                    }
                }
            }
        }
      }
      if (pi + 1 < a.nph) {
          if (a.nph > 4096) cg::this_grid().sync();
          else { XcdBarrier bar; bar.bar = (unsigned*)(WSP(a) + WS_BAR); bar.x = xb_xcc_id(); bar.st = (volatile LAS unsigned*)(lds_base + LDS_XBST); xcd_barrier(bar); }
      }
    }
}

#ifndef MK_LAUNCHES
#define MK_LAUNCHES 1
#endif
extern "C" void kernel_launch(void* const* d_in, const int* in_sizes, int n_in, void* d_out, int out_size, void* d_ws, size_t ws_size, hipStream_t stream) {
    static int grid = 0;
    if (grid == 0) {
        if (n_in != 23 || (size_t)out_size != O_END || ws_size < WS_END) { fprintf(stderr, "kernel_launch: unexpected shapes (n_in %d out %d ws %zu need %zu)\n", n_in, out_size, ws_size, (size_t)WS_END); grid = -1; return; }
        int dev = 0, cus = 0, per_cu = 0;
        hipGetDevice(&dev); hipDeviceGetAttribute(&cus, hipDeviceAttributeMultiprocessorCount, dev);
        if (hipFuncSetAttribute((const void*)hybrid_fwd, hipFuncAttributeMaxDynamicSharedMemorySize, LDS_BYTES) != hipSuccess) { fprintf(stderr, "kernel_launch: hipFuncSetAttribute failed\n"); grid = -1; return; }
        if (hipOccupancyMaxActiveBlocksPerMultiprocessor(&per_cu, (const void*)hybrid_fwd, 512, LDS_BYTES) != hipSuccess || per_cu < 1) { fprintf(stderr, "kernel_launch: occupancy query gave %d\n", per_cu); per_cu = 1; }
        (void)hipGetLastError();
        grid = cus * per_cu; if (grid > 256) grid = 256;
        fprintf(stderr, "kernel_launch: grid %d (cus %d per_cu %d)\n", grid, cus, per_cu);
    }
    if (grid < 0) return;
    Args a{};
    for (int i = 0; i < 23; ++i) a.in[i] = (const float*)d_in[i];
    a.out = (float*)d_out; a.ws = (unsigned char*)d_ws;
    int n = 0;
#ifdef PROBE_DUP
    for (int ph = 0; ph < N_PHASES; ++ph) { a.plist[n++] = (unsigned char)ph;
#ifdef PROBE_PH01
        if (ph < 2) a.plist[n++] = (unsigned char)ph;
#endif
        if (ph >= 2) { const int kk = (ph - 2) % 15; const int grp = (kk == 0 || kk == 2 || kk == 4 || kk == 9 || kk == 11 || kk == 13) ? 1 : (kk >= 5 && kk <= 7) ? 2 : 4;
            if (PROBE_DUP & grp) a.plist[n++] = (unsigned char)ph;
#ifdef PROBE_KK
            if ((PROBE_KK >> kk) & 1) a.plist[n++] = (unsigned char)ph;
#endif
        } }
#else
    for (int ph = 0; ph < N_PHASES; ++ph) {
#ifdef MINI_IN_GEMM
        if (ph >= 2 && ((ph - 2) % 15 == 1 || (ph - 2) % 15 == 12)) continue;
#endif
        a.plist[n++] = (unsigned char)ph; }
#endif
#ifdef PROBE_SYNC
    for (int i = 0; i < PROBE_SYNC; ++i) a.plist[n++] = (unsigned char)200;
#endif
    a.nph = n;
    if (hipMemsetAsync((char*)d_ws + WS_BAR, 0, 16384, stream) != hipSuccess) { fprintf(stderr, "kernel_launch: memset of barrier words failed\n"); return; }
    void* args[] = {&a};
    hipError_t e = hipLaunchCooperativeKernel((const void*)hybrid_fwd, dim3(grid), dim3(512), args, LDS_BYTES, stream);
    if (e != hipSuccess) fprintf(stderr, "cooperative launch failed: %s (grid %d)\n", hipGetErrorString(e), grid);
}
```
